# Optimizing an MI355X kernel written in HIP

```python
import jax, jax.numpy as jnp
from jax import lax
import numpy as np

D_MODEL = 4096
BATCH = 2
SEQ = 8192
DEPTH = 1

CHUNK = 64
HEAD_DIM = 128
N_SB_HEADS = 16
N_FOX_HEADS = 16
SB_WIDTH = N_SB_HEADS * HEAD_DIM
FOX_WIDTH = N_FOX_HEADS * HEAD_DIM
MIX_WIDTH = SB_WIDTH + FOX_WIDTH
IN_PROJ_DIM = 3 * SB_WIDTH + 3 * FOX_WIDTH + N_FOX_HEADS
SPLIT_POINTS = (SB_WIDTH, 2 * SB_WIDTH, 3 * SB_WIDTH,
                3 * SB_WIDTH + FOX_WIDTH, 3 * SB_WIDTH + 2 * FOX_WIDTH,
                3 * SB_WIDTH + 3 * FOX_WIDTH)
D_FF = 11008
FFN_RESIDUAL_SCALE = 0.5
Q_BLOCK = 128
EPS = 1e-6

kernel_name = "hybrid_sb_fox_macaron_block"


def rms_norm(x, g):
    xf = x.astype(jnp.float32)
    y = xf * lax.rsqrt(jnp.mean(xf * xf, axis=-1, keepdims=True) + EPS)
    return (y * g.astype(jnp.float32)).astype(x.dtype)


def swiglu(x, w_gate, w_up, w_down):
    return jnp.einsum('bsf,fd->bsd',
                      jax.nn.silu(jnp.einsum('bsd,df->bsf', x, w_gate)) * jnp.einsum('bsd,df->bsf', x, w_up),
                      w_down)


def to_heads(t, n_heads):
    b, s, _ = t.shape
    return t.reshape(b, s, n_heads, HEAD_DIM).transpose(0, 2, 1, 3)


def head_rms_norm(o, g):
    b, h, s, d = o.shape
    of = o.transpose(0, 2, 1, 3).astype(jnp.float32)
    y = of * lax.rsqrt(jnp.mean(of * of, axis=-1, keepdims=True) + EPS)
    y = y * g.astype(jnp.float32).reshape(h, d)
    return y.reshape(b, s, h * d).astype(o.dtype)


def stick_breaking_attention(q, k, v):
    b, h, s, d = q.shape
    nb = s // Q_BLOCK
    scale = d ** -0.5
    kpos = jnp.arange(s)
    q_blocks = q.reshape(b, h, nb, Q_BLOCK, d).transpose(2, 0, 1, 3, 4)

    def block(args):
        q_blk, i = args
        qpos = i * Q_BLOCK + jnp.arange(Q_BLOCK)
        z = jnp.einsum('bhqd,bhkd->bhqk', q_blk, k).astype(jnp.float32) * scale
        past = kpos[None, :] < qpos[:, None]
        log_keep = jnp.where(past, jax.nn.log_sigmoid(-z), 0.0)
        after = lax.cumsum(log_keep, axis=3, reverse=True) - log_keep
        a = jnp.where(past, jnp.exp(jax.nn.log_sigmoid(z) + after), 0.0)
        return jnp.einsum('bhqk,bhkd->bhqd', a.astype(v.dtype), v)

    out = lax.map(block, (q_blocks, jnp.arange(nb)))
    return out.transpose(1, 2, 0, 3, 4).reshape(b, h, s, d)


def forgetting_attention(q, k, v, log_f):
    b, h, s, d = q.shape
    nb = s // Q_BLOCK
    scale = d ** -0.5
    kpos = jnp.arange(s)
    c = jnp.cumsum(log_f, axis=-1)
    q_blocks = q.reshape(b, h, nb, Q_BLOCK, d).transpose(2, 0, 1, 3, 4)
    c_blocks = c.reshape(b, h, nb, Q_BLOCK).transpose(2, 0, 1, 3)

    def block(args):
        q_blk, c_blk, i = args
        qpos = i * Q_BLOCK + jnp.arange(Q_BLOCK)
        z = jnp.einsum('bhqd,bhkd->bhqk', q_blk, k).astype(jnp.float32) * scale
        z = z + c_blk[..., :, None] - c[..., None, :]
        causal = kpos[None, :] <= qpos[:, None]
        p = jax.nn.softmax(jnp.where(causal, z, -jnp.inf), axis=-1)
        return jnp.einsum('bhqk,bhkd->bhqd', p.astype(v.dtype), v)

    out = lax.map(block, (q_blocks, c_blocks, jnp.arange(nb)))
    return out.transpose(1, 2, 0, 3, 4).reshape(b, h, s, d)


def setup_inputs(seed: int = 0) -> dict:
    key = jax.random.key(seed)
    ks = jax.random.split(key, 17)

    def dense(k, fan_in, fan_out):
        return jax.random.normal(k, (DEPTH, fan_in, fan_out), jnp.float32) * fan_in ** -0.5

    def gain(k, n):
        return 1.0 + 0.02 * jax.random.normal(k, (DEPTH, n), jnp.float32)

    return {
        "x": jax.random.normal(ks[0], (BATCH, SEQ, D_MODEL), jnp.float32),
        "norm_ffn1_g": gain(ks[1], D_MODEL),
        "ffn1_w_gate": dense(ks[2], D_MODEL, D_FF),
        "ffn1_w_up": dense(ks[3], D_MODEL, D_FF),
        "ffn1_w_down": dense(ks[4], D_FF, D_MODEL),
        "norm_mix_g": gain(ks[5], D_MODEL),
        "w_in": dense(ks[6], D_MODEL, IN_PROJ_DIM),
        "b_f": jax.random.uniform(ks[7], (DEPTH, N_FOX_HEADS), jnp.float32, 1.0, 4.0),
        "sb_out_g": gain(ks[8], SB_WIDTH),
        "fox_out_g": gain(ks[9], FOX_WIDTH),
        "w_o": dense(ks[10], MIX_WIDTH, D_MODEL),
        "norm_ffn2_g": gain(ks[11], D_MODEL),
        "ffn2_w_gate": dense(ks[12], D_MODEL, D_FF),
        "ffn2_w_up": dense(ks[13], D_MODEL, D_FF),
        "ffn2_w_down": dense(ks[14], D_FF, D_MODEL),
        "norm_final_g": 1.0 + 0.02 * jax.random.normal(ks[15], (D_MODEL,), jnp.float32),
    }


def reference(x, norm_ffn1_g, ffn1_w_gate, ffn1_w_up, ffn1_w_down, norm_mix_g, w_in, b_f,
              sb_out_g, fox_out_g, w_o, norm_ffn2_g, ffn2_w_gate, ffn2_w_up, ffn2_w_down,
              norm_final_g):
    for l in range(DEPTH):
        h = rms_norm(x, norm_ffn1_g[l])
        x = x + FFN_RESIDUAL_SCALE * swiglu(h, ffn1_w_gate[l], ffn1_w_up[l], ffn1_w_down[l])

        h = rms_norm(x, norm_mix_g[l])
        proj = jnp.einsum('bsd,de->bse', h, w_in[l])
        qa, ka, va, qb, kb, vb, f_logit = jnp.split(proj, SPLIT_POINTS, axis=-1)

        o_sb = stick_breaking_attention(to_heads(qa, N_SB_HEADS), to_heads(ka, N_SB_HEADS),
                                        to_heads(va, N_SB_HEADS))
        log_f = jax.nn.log_sigmoid((f_logit + b_f[l]).astype(jnp.float32)).transpose(0, 2, 1)
        o_fox = forgetting_attention(to_heads(qb, N_FOX_HEADS), to_heads(kb, N_FOX_HEADS),
                                     to_heads(vb, N_FOX_HEADS), log_f)

        merged = jnp.concatenate([head_rms_norm(o_sb, sb_out_g[l]),
                                  head_rms_norm(o_fox, fox_out_g[l])], axis=-1)
        x = x + jnp.einsum('bse,ed->bsd', merged, w_o[l])

        h = rms_norm(x, norm_ffn2_g[l])
        x = x + FFN_RESIDUAL_SCALE * swiglu(h, ffn2_w_gate[l], ffn2_w_up[l], ffn2_w_down[l])
    return rms_norm(x, norm_final_g)
```

```cpp
#include <hip/hip_runtime.h>
#include <cstdio>
#include <cstdint>

#ifndef MK_N_LAUNCHES
#define MK_N_LAUNCHES 1
#endif
#ifndef PROBE_REP
#define PROBE_REP -1
#endif
#ifndef SB_EARLY_EXIT
#define SB_EARLY_EXIT 1
#endif

#define LAS __attribute__((address_space(3)))
#define GAS __attribute__((address_space(1)))
typedef unsigned short bf16_t;
typedef short bf16x8 __attribute__((ext_vector_type(8)));
typedef short s16x4 __attribute__((ext_vector_type(4)));
typedef float f32x4 __attribute__((ext_vector_type(4)));
typedef float f32x16 __attribute__((ext_vector_type(16)));
typedef unsigned u32x4 __attribute__((ext_vector_type(4)));
typedef unsigned u32x2 __attribute__((ext_vector_type(2)));

constexpr int BATCH = 2, SEQ = 8192, DM = 4096, DFF = 11008, M = BATCH * SEQ;
constexpr int NH = 16, HD = 128, GW = NH * HD;
constexpr int NQKV = 6 * GW;
constexpr int IN_PROJ = NQKV + NH;
constexpr float EPS = 1e-6f;
constexpr float L2E = 1.4426950408889634f;

__device__ __forceinline__ unsigned cvt_pk_bf16(float lo, float hi) { unsigned r; asm volatile("v_cvt_pk_bf16_f32 %0, %1, %2" : "=v"(r) : "v"(lo), "v"(hi)); return r; }
__device__ __forceinline__ float ld_agent_f32(const float* p) { return __uint_as_float(__hip_atomic_load((const unsigned*)p, __ATOMIC_RELAXED, __HIP_MEMORY_SCOPE_AGENT)); }
__device__ __forceinline__ float rstd_of(float ss) { return __builtin_amdgcn_rsqf(ss * (1.0f / DM) + EPS); }

namespace pg8 {
constexpr int BM = 256, BK = 64, HALF = 128, HTB = HALF * BK * 2, STAGE_BYTES = 8 * HTB, NXCD = 8, WGM = 8;
__host__ __device__ __forceinline__ int lds_byte(int r, int c) { const int st = (r >> 4) * 2 + (c >> 5), rr = r & 15, cc = c & 31, ob = rr * 64 + cc * 2; return st * 1024 + (ob ^ (((ob >> 9) & 1) << 5)); }
__host__ __device__ __forceinline__ void stage_rc(int b, int& R, int& C) { const int st = b / 1024, sb = b % 1024, swz = sb ^ (((sb >> 9) & 1) << 5); R = (st >> 1) * 16 + swz / 64; C = (st & 1) * 32 + (swz % 64) / 2; }
__host__ __device__ __forceinline__ int perm32(int rho) { const int n = rho >> 4, i = rho & 15; return 8 * (i >> 2) + 4 * n + (i & 3); }
struct Unit { int pm, pn; };
struct Gemm { const bf16_t* A; const bf16_t* Bt; int M, N, K; };
__host__ __device__ __forceinline__ size_t img_off(int row, int col, int K) { return ((size_t)((row >> 8) * (K >> 6) + (col >> 6)) * 2 + ((row >> 7) & 1)) * 8192 + (size_t)(lds_byte(row & 127, col & 63) >> 1); }
__host__ __device__ __forceinline__ int perm32inv(int w) { return 16 * ((w >> 2) & 1) + 4 * (w >> 3) + (w & 3); }
__host__ __device__ __forceinline__ size_t img_off_b(int n, int k, int K) { return img_off((n & ~31) + perm32inv(n & 31), k, K); }
struct StaticOrder {
    static constexpr bool DYNAMIC = false;
    int nM, nN, nwg, G, c, wgm;
    __host__ __device__ void init(int M_, int N_, int G_, int c_, int wgm_ = WGM) { nM = M_ / BM; nN = N_ / BM; nwg = nM * nN; G = G_; c = c_; wgm = wgm_; }
    __host__ __device__ bool next(int i, Unit& u) const {
        const long L = (long)i * G + c; if (L >= nwg) return false;
        int wgid = (int)L; { const int q = nwg / NXCD, r = nwg % NXCD, xcd = wgid % NXCD, off = wgid / NXCD; wgid = (xcd < r ? xcd * (q + 1) : r * (q + 1) + (xcd - r) * q) + off; }
        const int nig = wgm * nN, gid = wgid / nig, fm = gid * wgm, gsz = (nM - fm) < wgm ? (nM - fm) : wgm;
        u.pm = fm + ((wgid % nig) % gsz); u.pn = (wgid % nig) / gsz; return true;
    }
    __device__ __forceinline__ void a_ready(const Unit&) const {}
    __device__ __forceinline__ void done(const Unit&) const {}
};
struct DynOrder {
    static constexpr bool DYNAMIC = true;
    unsigned* heads; int per, home; volatile LAS int* slot;
    __device__ __forceinline__ void decode(int id, Unit& u) const { const int q = id / per, off = id - q * per; u.pm = 8 * q + (off & 7); u.pn = off >> 3; }
    __device__ __forceinline__ int pop_from(int k0) const {
        for (int k = k0; k < 8; ++k) { const int q = (home + k) & 7; const unsigned off = __hip_atomic_fetch_add(heads + 64 * q, 1u, __ATOMIC_RELAXED, __HIP_MEMORY_SCOPE_AGENT); if (off < (unsigned)per) return q * per + (int)off; }
        return -1;
    }
    __device__ __forceinline__ bool next(int, Unit&) const { return false; }
    __device__ __forceinline__ void a_ready(const Unit&) const {}
    __device__ __forceinline__ void done(const Unit&) const {}
};


using f32x2 = __attribute__((ext_vector_type(2))) float;
struct EpiSwiglu {
    static constexpr bool PERM = true, AFTER_DRAIN = false;
    bf16_t* H; const float* rowss;
    __device__ __forceinline__ void operator()(const f32x4 (&acc)[2][2][4][2], const Unit& u, int wr, int wc, int fr, int fq) const {
        const int row0 = u.pm * BM + wr * 64 + fr, col0 = u.pn * HALF + wc * 32 + 8 * fq;
        float rs[2][4];
#pragma unroll
        for (int ai = 0; ai < 2; ++ai)
#pragma unroll
            for (int m = 0; m < 4; ++m) rs[ai][m] = ld_agent_f32(rowss + row0 + ai * HALF + m * 16);
#pragma unroll
        for (int ai = 0; ai < 2; ++ai)
#pragma unroll
            for (int m = 0; m < 4; ++m) {
                const int row = row0 + ai * HALF + m * 16; const float r = rstd_of(rs[ai][m]);
                const f32x2 rn = {-L2E * r, -L2E * r}, r2 = {r * r, r * r}; f32x2 t[4], p[4];
#pragma unroll
                for (int k = 0; k < 4; ++k) { const f32x2 g = {acc[ai][0][m][k >> 1][2 * (k & 1)], acc[ai][0][m][k >> 1][2 * (k & 1) + 1]}, up = {acc[ai][1][m][k >> 1][2 * (k & 1)], acc[ai][1][m][k >> 1][2 * (k & 1) + 1]};
                    t[k] = g * rn; p[k] = (g * up) * r2; }
#pragma unroll
                for (int k = 0; k < 4; ++k) { t[k].x = __builtin_amdgcn_exp2f(t[k].x); t[k].y = __builtin_amdgcn_exp2f(t[k].y); }
#pragma unroll
                for (int k = 0; k < 4; ++k) t[k] = t[k] + (f32x2){1.0f, 1.0f};
#pragma unroll
                for (int k = 0; k < 4; ++k) { t[k].x = __builtin_amdgcn_rcpf(t[k].x); t[k].y = __builtin_amdgcn_rcpf(t[k].y); }
#pragma unroll
                for (int k = 0; k < 4; ++k) p[k] = p[k] * t[k];
                u32x4 w; w.x = cvt_pk_bf16(p[0].x, p[0].y); w.y = cvt_pk_bf16(p[1].x, p[1].y); w.z = cvt_pk_bf16(p[2].x, p[2].y); w.w = cvt_pk_bf16(p[3].x, p[3].y);
                *(u32x4*)(H + img_off(row, col0, DFF)) = w; }
    }
};
template <bool BASE_BF16, bool OUT_F32>
struct EpiResid {
    static constexpr bool PERM = true, AFTER_DRAIN = false;
    const void* base; void* out; float* rowss; float scale;
    __device__ __forceinline__ void operator()(const f32x4 (&acc)[2][2][4][2], const Unit& u, int wr, int wc, int fr, int fq) const {
        const int row0 = u.pm * BM + wr * 64 + fr, col0 = u.pn * BM + wc * 32 + 8 * fq;
#pragma unroll
        for (int ai = 0; ai < 2; ++ai) {
            f32x4 bv[4][2][2];
#pragma unroll
            for (int m = 0; m < 4; ++m) { const int row = row0 + ai * HALF + m * 16; const size_t off = (size_t)row * DM + col0;
#pragma unroll
                for (int bj = 0; bj < 2; ++bj) {
                    if (BASE_BF16) { const u32x4 w = *(const u32x4*)((const bf16_t*)base + img_off(row, col0 + bj * HALF, DM));
                        bv[m][bj][0] = (f32x4){__uint_as_float(w.x << 16), __uint_as_float(w.x & 0xffff0000u), __uint_as_float(w.y << 16), __uint_as_float(w.y & 0xffff0000u)};
                        bv[m][bj][1] = (f32x4){__uint_as_float(w.z << 16), __uint_as_float(w.z & 0xffff0000u), __uint_as_float(w.w << 16), __uint_as_float(w.w & 0xffff0000u)}; }
                    else { bv[m][bj][0] = *(const f32x4*)((const float*)base + off + bj * HALF); bv[m][bj][1] = *(const f32x4*)((const float*)base + off + bj * HALF + 4); } } }
            asm volatile("" ::: "memory");
#pragma unroll
            for (int m = 0; m < 4; ++m) {
                const int row = row0 + ai * HALF + m * 16; const size_t off = (size_t)row * DM + col0; float ss = 0.f;
#pragma unroll
                for (int bj = 0; bj < 2; ++bj) {
                    const f32x4 v0 = bv[m][bj][0] + acc[ai][bj][m][0] * scale, v1 = bv[m][bj][1] + acc[ai][bj][m][1] * scale;
                    ss += (v0[0] * v0[0] + v0[1] * v0[1]) + (v0[2] * v0[2] + v0[3] * v0[3]) + (v1[0] * v1[0] + v1[1] * v1[1]) + (v1[2] * v1[2] + v1[3] * v1[3]);
                    if (OUT_F32) { *(f32x4*)((float*)out + off + bj * HALF) = v0; *(f32x4*)((float*)out + off + bj * HALF + 4) = v1; }
                    else { u32x4 w; w.x = cvt_pk_bf16(v0[0], v0[1]); w.y = cvt_pk_bf16(v0[2], v0[3]); w.z = cvt_pk_bf16(v1[0], v1[1]); w.w = cvt_pk_bf16(v1[2], v1[3]);
                        *(u32x4*)((bf16_t*)out + img_off(row, col0 + bj * HALF, DM)) = w; } }
                ss += __shfl_xor(ss, 16); ss += __shfl_xor(ss, 32);
                if (fq == 0) __hip_atomic_fetch_add(rowss + row, ss, __ATOMIC_RELAXED, __HIP_MEMORY_SCOPE_AGENT); }
        }
    }
};
struct EpiResidNorm {
    static constexpr bool PERM = true, AFTER_DRAIN = false;
    const bf16_t* base; float* out; float* rowss; unsigned* cnt; const float* gain; float scale;
    __device__ __forceinline__ void operator()(const f32x4 (&acc_c)[2][2][4][2], const Unit& u, int wr, int wc, int fr, int fq) const {
        f32x4 (&acc)[2][2][4][2] = const_cast<f32x4 (&)[2][2][4][2]>(acc_c);
        const int row0 = u.pm * BM + wr * 64 + fr, col0 = u.pn * BM + wc * 32 + 8 * fq;
#pragma unroll
        for (int ai = 0; ai < 2; ++ai) {
            u32x4 bw[4][2];
#pragma unroll
            for (int m = 0; m < 4; ++m) {
#pragma unroll
                for (int bj = 0; bj < 2; ++bj) bw[m][bj] = *(const u32x4*)(base + img_off(row0 + ai * HALF + m * 16, col0 + bj * HALF, DM)); }
#pragma unroll
            for (int m = 0; m < 4; ++m) { float ss = 0.f;
#pragma unroll
                for (int bj = 0; bj < 2; ++bj) { const u32x4 w = bw[m][bj];
                    const f32x4 b0 = {__uint_as_float(w.x << 16), __uint_as_float(w.x & 0xffff0000u), __uint_as_float(w.y << 16), __uint_as_float(w.y & 0xffff0000u)};
                    const f32x4 b1 = {__uint_as_float(w.z << 16), __uint_as_float(w.z & 0xffff0000u), __uint_as_float(w.w << 16), __uint_as_float(w.w & 0xffff0000u)};
                    const f32x4 v0 = b0 + acc[ai][bj][m][0] * scale, v1 = b1 + acc[ai][bj][m][1] * scale; acc[ai][bj][m][0] = v0; acc[ai][bj][m][1] = v1;
                    ss += (v0[0] * v0[0] + v0[1] * v0[1]) + (v0[2] * v0[2] + v0[3] * v0[3]) + (v1[0] * v1[0] + v1[1] * v1[1]) + (v1[2] * v1[2] + v1[3] * v1[3]); }
                ss += __shfl_xor(ss, 16); ss += __shfl_xor(ss, 32);
                if (fq == 0) __hip_atomic_fetch_add(rowss + row0 + ai * HALF + m * 16, ss, __ATOMIC_RELAXED, __HIP_MEMORY_SCOPE_AGENT); }
        }
        asm volatile("s_waitcnt vmcnt(0)" ::: "memory");
        unsigned* pc = cnt + 64 * u.pm;
        if (fr == 0 && fq == 0) __hip_atomic_fetch_add(pc, 1u, __ATOMIC_RELAXED, __HIP_MEMORY_SCOPE_AGENT);
        { unsigned spins = 0;
          while ((unsigned)__builtin_amdgcn_readfirstlane(__hip_atomic_load(pc, __ATOMIC_RELAXED, __HIP_MEMORY_SCOPE_AGENT)) < 128u) { __builtin_amdgcn_s_sleep(2); if (++spins > (1u << 22)) break; } }
        f32x4 g0[2], g1[2];
#pragma unroll
        for (int bj = 0; bj < 2; ++bj) { g0[bj] = *(const f32x4*)(gain + col0 + bj * HALF); g1[bj] = *(const f32x4*)(gain + col0 + bj * HALF + 4); }
        float rs[2][4];
#pragma unroll
        for (int ai = 0; ai < 2; ++ai)
#pragma unroll
            for (int m = 0; m < 4; ++m) rs[ai][m] = ld_agent_f32(rowss + row0 + ai * HALF + m * 16);
#pragma unroll
        for (int ai = 0; ai < 2; ++ai)
#pragma unroll
            for (int m = 0; m < 4; ++m) { const int row = row0 + ai * HALF + m * 16; const float r = rstd_of(rs[ai][m]); float* op = out + (size_t)row * DM + col0;
#pragma unroll
                for (int bj = 0; bj < 2; ++bj) { *(f32x4*)(op + bj * HALF) = acc[ai][bj][m][0] * r * g0[bj]; *(f32x4*)(op + bj * HALF + 4) = acc[ai][bj][m][1] * r * g1[bj]; } }
    }
};
struct EpiQKV {
    static constexpr bool PERM = true, AFTER_DRAIN = false;
    bf16_t* O; const float* rowss; float* tmx;
    __device__ __forceinline__ void operator()(const f32x4 (&acc)[2][2][4][2], const Unit& u, int wr, int wc, int fr, int fq) const {
        const int row0 = u.pm * BM + wr * 64 + fr; const int colt = u.pn * BM, t = colt >> 11, cin = colt & (GW - 1);
        bf16_t* basep = O + (size_t)t * ((size_t)M * GW) + cin + wc * 32 + 8 * fq;
        float rs[2][4];
#pragma unroll
        for (int ai = 0; ai < 2; ++ai)
#pragma unroll
            for (int m = 0; m < 4; ++m) rs[ai][m] = rstd_of(ld_agent_f32(rowss + row0 + ai * HALF + m * 16));
#pragma unroll
        for (int ai = 0; ai < 2; ++ai)
#pragma unroll
            for (int m = 0; m < 4; ++m) {
                const int row = row0 + ai * HALF + m * 16; const float r = rs[ai][m]; bf16_t* rowp = basep + (size_t)row * GW;
#pragma unroll
                for (int bj = 0; bj < 2; ++bj) { const f32x4 v0 = acc[ai][bj][m][0] * r, v1 = acc[ai][bj][m][1] * r;
                    u32x4 w; w.x = cvt_pk_bf16(v0[0], v0[1]); w.y = cvt_pk_bf16(v0[2], v0[3]); w.z = cvt_pk_bf16(v1[0], v1[1]); w.w = cvt_pk_bf16(v1[2], v1[3]);
                    *(u32x4*)(rowp + bj * HALF) = w; } }
        if (t == 4) {
#pragma unroll
            for (int ai = 0; ai < 2; ++ai)
#pragma unroll
                for (int bj = 0; bj < 2; ++bj) {
                    float mx = 0.f;
#pragma unroll
                    for (int m = 0; m < 4; ++m) { const f32x4 v0 = acc[ai][bj][m][0] * rs[ai][m], v1 = acc[ai][bj][m][1] * rs[ai][m];
                        float s = (v0[0] * v0[0] + v0[1] * v0[1]) + (v0[2] * v0[2] + v0[3] * v0[3]) + (v1[0] * v1[0] + v1[1] * v1[1]) + (v1[2] * v1[2] + v1[3] * v1[3]);
                        s += __shfl_xor(s, 16); s += __shfl_xor(s, 32); mx = fmaxf(mx, s); }
                    mx = fmaxf(mx, __shfl_xor(mx, 1)); mx = fmaxf(mx, __shfl_xor(mx, 2)); mx = fmaxf(mx, __shfl_xor(mx, 4)); mx = fmaxf(mx, __shfl_xor(mx, 8));
                    const int rowt = u.pm * BM + ai * HALF + wr * 64, bb = rowt / SEQ, tile = (rowt % SEQ) >> 6, head = (cin >> 7) + bj;
                    if (fr == 0 && fq == 0) __hip_atomic_fetch_add(tmx + (bb * NH + head) * 128 + tile, mx, __ATOMIC_RELAXED, __HIP_MEMORY_SCOPE_AGENT); }
        }
    }
};

template <class Epi, class Sched, bool ALIGN_EPI = false, bool SP2 = false>
__device__ __forceinline__ void gemm_phase(LAS unsigned char* lds, const Gemm g, const Sched& S, const Epi& E) {
    const int tid = threadIdx.x, wid = __builtin_amdgcn_readfirstlane(tid >> 6), lane = tid & 63, wr = wid >> 2, wc = wid & 3, fr = lane & 15, fq = lane >> 4;
    const int K = g.K, nt = K / BK;
    static_assert(Epi::PERM, "the B images are stored with the perm32 row order");
    unsigned voffA[2], voffB[2];
#pragma unroll
    for (int i = 0; i < 2; ++i) { voffA[i] = (unsigned)(tid * 16 + i * 8192); voffB[i] = voffA[i]; }
    const size_t kstep = (size_t)(BM * BK * 2);
    const size_t hstep = (size_t)(HALF * BK * 2);
    const size_t tstep = (size_t)BM * K * 2;
    const unsigned ldsw = (unsigned)wid * 1024u;
    const int aoff = lds_byte(wr * 64 + fr, fq * 8), boff = lds_byte(wc * 32 + fr, fq * 8);
#define PG8_SA(b, h) (((b) * 2 + (h)) * HTB)
#define PG8_SB(b, h) ((4 + (b) * 2 + (h)) * HTB)
    const unsigned ldsbase = (unsigned)__builtin_amdgcn_readfirstlane((int)((unsigned)(uintptr_t)lds + ldsw));
#define PG8_STAGE(bufoff, gbase, voff) do { _Pragma("unroll") for (int _i = 0; _i < 2; ++_i) { \
        asm volatile("s_add_i32 m0, %2, %3\n\ts_nop 0\n\tglobal_load_lds_dwordx4 %0, %1" \
                     :: "v"((voff)[_i]), "s"((const void*)(gbase)), "s"(ldsbase), "n"((bufoff) + _i * 8192) : "memory", "m0", "scc"); } } while (0)
#define PG8_LDA(dst, b, h) do { _Pragma("unroll") for (int m = 0; m < 4; ++m) _Pragma("unroll") for (int k = 0; k < 2; ++k) dst[m][k] = *(const LAS bf16x8*)(lds + PG8_SA(b, h) + aoff + m * 2048 + k * 1024); } while (0)
#define PG8_LDB(dst, b, h) do { _Pragma("unroll") for (int n = 0; n < 2; ++n) _Pragma("unroll") for (int k = 0; k < 2; ++k) dst[n][k] = *(const LAS bf16x8*)(lds + PG8_SB(b, h) + boff + n * 2048 + k * 1024); } while (0)
#define PG8_MMA(ai, bj, At, Bt) do { __builtin_amdgcn_s_setprio(1); _Pragma("unroll") for (int m = 0; m < 4; ++m) _Pragma("unroll") for (int n = 0; n < 2; ++n) _Pragma("unroll") for (int k = 0; k < 2; ++k) \
        acc[ai][bj][m][n] = __builtin_amdgcn_mfma_f32_16x16x32_bf16(Bt[n][k], At[m][k], acc[ai][bj][m][n], 0, 0, 0); __builtin_amdgcn_s_setprio(0); } while (0)
#define PG8_WAIT_V(n) asm volatile("s_waitcnt vmcnt(" #n ")" ::: "memory")
#define PG8_WAIT_L(n) asm volatile("s_waitcnt lgkmcnt(" #n ")" ::: "memory")
#define PG8_BAR __builtin_amdgcn_s_barrier()
#define PG8_SCHED __builtin_amdgcn_sched_barrier(0)
    Unit cur, nxt; int ui = 0;
    if constexpr (Sched::DYNAMIC) {
        if (tid == 0) S.slot[0] = S.pop_from(0);
        __syncthreads();
        const int id0 = S.slot[0]; if (id0 < 0) return;
        S.decode(id0, cur);
    } else { if (!S.next(0, cur)) return; }
    f32x4 acc[2][2][4][2];
#pragma unroll
    for (int a = 0; a < 2; ++a)
#pragma unroll
        for (int b = 0; b < 2; ++b)
#pragma unroll
            for (int m = 0; m < 4; ++m)
#pragma unroll
                for (int n = 0; n < 2; ++n) acc[a][b][m][n] = (f32x4){0.f, 0.f, 0.f, 0.f};
    bf16x8 At[4][2], B0[2][2], B1[2][2];
    const char* cA = (const char*)g.A + (size_t)cur.pm * tstep; const char* cB = (const char*)g.Bt + (size_t)cur.pn * tstep;
    S.a_ready(cur);
    if constexpr (SP2) {
        PG8_STAGE(PG8_SB(0, 0), cB, voffB); PG8_STAGE(PG8_SB(0, 1), cB + hstep, voffB); PG8_STAGE(PG8_SA(0, 0), cA, voffA); PG8_STAGE(PG8_SA(0, 1), cA + hstep, voffA);
        if (wr == 1) PG8_BAR;
        PG8_WAIT_V(2); PG8_BAR;
        PG8_STAGE(PG8_SB(1, 0), cB + kstep, voffB); PG8_STAGE(PG8_SA(1, 0), cA + kstep, voffA); PG8_STAGE(PG8_SB(1, 1), cB + hstep + kstep, voffB);
        PG8_WAIT_V(6); PG8_BAR;
    } else {
        PG8_STAGE(PG8_SB(0, 0), cB, voffB); PG8_STAGE(PG8_SA(0, 0), cA, voffA); PG8_STAGE(PG8_SB(0, 1), cB + hstep, voffB); PG8_STAGE(PG8_SA(0, 1), cA + hstep, voffA);
        if (wr == 1) PG8_BAR;
        PG8_WAIT_V(4); PG8_BAR;
        PG8_STAGE(PG8_SB(1, 0), cB + kstep, voffB); PG8_STAGE(PG8_SA(1, 0), cA + kstep, voffA); PG8_STAGE(PG8_SB(1, 1), cB + hstep + kstep, voffB);
        PG8_WAIT_V(6); PG8_BAR;
    }
    for (;;) {
        bool has_next = false; const char* nA = cA; const char* nB = cB; unsigned popv = 0;
        if constexpr (!Sched::DYNAMIC) { has_next = S.next(ui + 1, nxt); if (has_next) { nA = (const char*)g.A + (size_t)nxt.pm * tstep; nB = (const char*)g.Bt + (size_t)nxt.pn * tstep; } }
        for (int t = 0; t < nt; t += 2) {
            const bool last = (t == nt - 2);
            if constexpr (Sched::DYNAMIC) {
                if (t == nt - 6 && tid == 0) asm volatile("global_atomic_add %0, %1, %2, %3 sc0" : "=v"(popv) : "v"(0u), "v"(1u), "s"(S.heads + 64 * S.home) : "memory");
                if (t == nt - 4 && tid == 0) S.slot[(ui + 1) & 1] = (popv < (unsigned)S.per) ? S.home * S.per + (int)popv : S.pop_from(1);
                if (last) { const int idn = S.slot[(ui + 1) & 1]; has_next = idn >= 0; if (has_next) { S.decode(idn, nxt); nA = (const char*)g.A + (size_t)nxt.pm * tstep; nB = (const char*)g.Bt + (size_t)nxt.pn * tstep; } }
            }
            const char* a1 = cA + (size_t)(t + 1) * kstep;
            const char* a2 = last ? nA : cA + (size_t)(t + 2) * kstep; const char* b2 = last ? nB : cB + (size_t)(t + 2) * kstep;
            const char* a3 = a2 + kstep; const char* b3 = b2 + kstep;
            if (last && has_next) S.a_ready(nxt);
            if constexpr (SP2) {
            PG8_LDB(B0, 0, 0); PG8_LDB(B1, 0, 1); PG8_SCHED; PG8_LDA(At, 0, 0); PG8_STAGE(PG8_SA(1, 1), a1 + hstep, voffA);
            PG8_WAIT_V(8); PG8_WAIT_L(0); PG8_BAR; PG8_MMA(0, 0, At, B0); PG8_MMA(0, 1, At, B1); PG8_BAR; PG8_SCHED;
            PG8_LDA(At, 0, 1); PG8_STAGE(PG8_SB(0, 0), b2, voffB); PG8_STAGE(PG8_SB(0, 1), b2 + hstep, voffB); PG8_STAGE(PG8_SA(0, 0), a2, voffA);
            PG8_WAIT_V(8); PG8_WAIT_L(0); PG8_BAR; PG8_MMA(1, 0, At, B0); PG8_MMA(1, 1, At, B1); PG8_BAR; PG8_SCHED;
            PG8_LDB(B0, 1, 0); PG8_LDB(B1, 1, 1); PG8_SCHED; PG8_LDA(At, 1, 0); PG8_STAGE(PG8_SA(0, 1), a2 + hstep, voffA);
            PG8_WAIT_V(8); PG8_WAIT_L(0); PG8_BAR; PG8_MMA(0, 0, At, B0); PG8_MMA(0, 1, At, B1); PG8_BAR; PG8_SCHED;
            PG8_LDA(At, 1, 1); PG8_STAGE(PG8_SB(1, 0), b3, voffB); PG8_STAGE(PG8_SB(1, 1), b3 + hstep, voffB); PG8_STAGE(PG8_SA(1, 0), a3, voffA);
            PG8_WAIT_V(8); PG8_WAIT_L(0); PG8_BAR; PG8_MMA(1, 0, At, B0); PG8_MMA(1, 1, At, B1); PG8_BAR; PG8_SCHED;
            } else {
            PG8_LDB(B0, 0, 0); PG8_SCHED; PG8_LDA(At, 0, 0); PG8_STAGE(PG8_SA(1, 1), a1 + hstep, voffA);
            PG8_WAIT_L(8); PG8_BAR; PG8_WAIT_L(0); PG8_MMA(0, 0, At, B0); PG8_BAR; PG8_SCHED;
            PG8_LDB(B1, 0, 1); PG8_STAGE(PG8_SB(0, 0), b2, voffB);
            PG8_BAR; PG8_WAIT_L(0); PG8_MMA(0, 1, At, B1); PG8_BAR;
            PG8_LDA(At, 0, 1); PG8_STAGE(PG8_SA(0, 0), a2, voffA);
            PG8_BAR; PG8_WAIT_L(0); PG8_MMA(1, 0, At, B0); PG8_BAR; PG8_SCHED;
            PG8_STAGE(PG8_SB(0, 1), b2 + hstep, voffB);
            PG8_WAIT_V(6); PG8_BAR; PG8_MMA(1, 1, At, B1); PG8_BAR;
            PG8_LDB(B0, 1, 0); PG8_SCHED; PG8_LDA(At, 1, 0); PG8_STAGE(PG8_SA(0, 1), a2 + hstep, voffA);
            PG8_WAIT_L(8); PG8_BAR; PG8_WAIT_L(0); PG8_MMA(0, 0, At, B0); PG8_BAR; PG8_SCHED;
            PG8_LDB(B1, 1, 1); PG8_STAGE(PG8_SB(1, 0), b3, voffB);
            PG8_BAR; PG8_WAIT_L(0); PG8_MMA(0, 1, At, B1); PG8_BAR;
            PG8_LDA(At, 1, 1); PG8_STAGE(PG8_SA(1, 0), a3, voffA);
            PG8_BAR; PG8_WAIT_L(0); PG8_MMA(1, 0, At, B0); PG8_BAR; PG8_SCHED;
            PG8_STAGE(PG8_SB(1, 1), b3 + hstep, voffB);
            PG8_WAIT_V(6); PG8_BAR; PG8_MMA(1, 1, At, B1); PG8_BAR;
            }
        }
        if constexpr (ALIGN_EPI) { if (wr == 0) PG8_BAR; }
        if constexpr (!Epi::AFTER_DRAIN) { E(acc, cur, wr, wc, fr, fq); S.done(cur); }
        if (!has_next) break;
#pragma unroll
        for (int a = 0; a < 2; ++a)
#pragma unroll
            for (int b = 0; b < 2; ++b)
#pragma unroll
                for (int m = 0; m < 4; ++m)
#pragma unroll
                    for (int n = 0; n < 2; ++n) acc[a][b][m][n] = (f32x4){0.f, 0.f, 0.f, 0.f};
        cur = nxt; cA = nA; cB = nB; ++ui;
        if constexpr (ALIGN_EPI) { if (wr == 1) PG8_BAR; }
    }
    PG8_WAIT_V(0);
    if constexpr (!ALIGN_EPI) { if (wr == 0) PG8_BAR; }
    PG8_BAR;
#undef PG8_SA
#undef PG8_SB
#undef PG8_STAGE
#undef PG8_LDA
#undef PG8_LDB
#undef PG8_MMA
#undef PG8_WAIT_V
#undef PG8_WAIT_L
#undef PG8_BAR
#undef PG8_SCHED
}
}

namespace att {
constexpr int PITCH = GW, QB = 256, KVBLK = 64, SHM = 16384;
constexpr float SCALE = 0.08838834764831845f;
constexpr float C2 = SCALE * L2E;
constexpr int OFF_K = 65536, OFF_WS = 114688, OFF_CB = 116736, OFF_KP = 117248, OFF_CLB = 117760, OFF_VOTE = 118528, OFF_SLOT = 118592, ATT_LDS_BYTES = 118592 + 64;
#define KSWZ(row, colB) ((row) * 256 + ((colB) ^ (((row) & 7) << 4)))
#define SBAR() __builtin_amdgcn_sched_barrier(0)
__device__ __forceinline__ int v_st(int k, int c) { const int kk = (k & ~0xC) | ((k & 4) << 1) | ((k & 8) >> 1); return ((kk >> 3) * 4 + (c >> 5)) * 512 + ((kk & 7) * 32 + (c & 31)) * 2; }
__device__ __forceinline__ int v_rd_base(int lane) { return ((lane & 3) << 3) | (((lane >> 2) & 3) << 6) | (((lane >> 4) & 1) << 5) | (((lane >> 5) & 1) << 8); }
constexpr int v_rd_off(int d0, int ks, int half) { return d0 * 512 + ks * 4096 + half * 2048; }
__device__ __forceinline__ int crow(int r, int hi) { return (r & 3) + 8 * (r >> 2) + 4 * hi; }
__device__ __forceinline__ float partner(float x, int hi) { auto rr = __builtin_amdgcn_permlane32_swap(__float_as_uint(x), __float_as_uint(x), false, false); return __uint_as_float(hi ? rr[0] : rr[1]); }

__device__ __forceinline__ void qkt(f32x16& p0, f32x16& p1, LAS const unsigned char* Kt, int r32, int hi, const bf16x8* qr) {
    LAS const unsigned char* kb[4];
#pragma unroll
    for (int dd = 0; dd < 4; ++dd) kb[dd] = Kt + KSWZ(r32, (dd * 16 + hi * 8) * 2);
#pragma unroll
    for (int d0 = 0; d0 < 8; ++d0) { LAS const unsigned char* a = kb[d0 & 3] + (d0 >> 2) * 128;
        const bf16x8 b0 = *(LAS const bf16x8*)a;
        const bf16x8 b1 = *(LAS const bf16x8*)(a + 32 * 256);
        p0 = __builtin_amdgcn_mfma_f32_32x32x16_bf16(b0, qr[d0], p0, 0, 0, 0);
        p1 = __builtin_amdgcn_mfma_f32_32x32x16_bf16(b1, qr[d0], p1, 0, 0, 0); }
}
__device__ __forceinline__ void pv_tile(f32x16* o, int vb0, bf16x8 pa0, bf16x8 pa1, bf16x8 pa2, bf16x8 pa3) {
#define TRRD(dst, off) asm volatile("ds_read_b64_tr_b16 %0, %1 offset:%2" : "=&v"(dst) : "v"(vb0), "i"(off) : "memory")
#define PV_D0(d0) do { s16x4 l0, l1, l2, l3, h0, h1, h2, h3; constexpr int b_ = v_rd_off(d0, 0, 0); \
        TRRD(l0, b_); TRRD(h0, b_ + 2048); TRRD(l1, b_ + 4096); TRRD(h1, b_ + 6144); TRRD(l2, b_ + 8192); TRRD(h2, b_ + 10240); TRRD(l3, b_ + 12288); TRRD(h3, b_ + 14336); \
        asm volatile("s_waitcnt lgkmcnt(0)" ::: "memory"); SBAR(); \
        o[d0] = __builtin_amdgcn_mfma_f32_32x32x16_bf16(pa0, (bf16x8){l0[0], l0[1], l0[2], l0[3], h0[0], h0[1], h0[2], h0[3]}, o[d0], 0, 0, 0); \
        o[d0] = __builtin_amdgcn_mfma_f32_32x32x16_bf16(pa1, (bf16x8){l1[0], l1[1], l1[2], l1[3], h1[0], h1[1], h1[2], h1[3]}, o[d0], 0, 0, 0); \
        o[d0] = __builtin_amdgcn_mfma_f32_32x32x16_bf16(pa2, (bf16x8){l2[0], l2[1], l2[2], l2[3], h2[0], h2[1], h2[2], h2[3]}, o[d0], 0, 0, 0); \
        o[d0] = __builtin_amdgcn_mfma_f32_32x32x16_bf16(pa3, (bf16x8){l3[0], l3[1], l3[2], l3[3], h3[0], h3[1], h3[2], h3[3]}, o[d0], 0, 0, 0); } while (0)
    PV_D0(0); PV_D0(1); PV_D0(2); PV_D0(3);
#undef PV_D0
#undef TRRD
}
__device__ __forceinline__ void pack_p(const f32x16& p0, const f32x16& p1, bf16x8& pa0, bf16x8& pa1, bf16x8& pa2, bf16x8& pa3) {
#define PK4(P, B_, OUT) do { unsigned a0 = cvt_pk_bf16(P[B_+0], P[B_+1]), a1 = cvt_pk_bf16(P[B_+2], P[B_+3]); \
        unsigned b0 = cvt_pk_bf16(P[B_+4], P[B_+5]), b1 = cvt_pk_bf16(P[B_+6], P[B_+7]); \
        auto r0 = __builtin_amdgcn_permlane32_swap(a0, b0, false, false); auto r1 = __builtin_amdgcn_permlane32_swap(a1, b1, false, false); \
        u32x4 w = {r0[0], r1[0], r0[1], r1[1]}; OUT = __builtin_bit_cast(bf16x8, w); } while (0)
    PK4(p0, 0, pa0); PK4(p0, 8, pa1); PK4(p1, 0, pa2); PK4(p1, 8, pa3);
#undef PK4
}
template <bool NORM_L>
__device__ __forceinline__ void head_epilogue(f32x16* o, float l_own, LAS unsigned char* lds, int wid, int r32, int hi, const float* gain, bf16_t* Mrg, int grow0  , int gcol0  ) {
    LAS float* li_l = (LAS float*)(lds + OFF_WS) + wid * 64;
    if (NORM_L) {
        const float l = l_own + partner(l_own, hi);
        if (hi == 0) li_l[r32] = l;
        asm volatile("s_waitcnt lgkmcnt(0)" ::: "memory");
#pragma unroll
        for (int r = 0; r < 16; ++r) { const float rl = __builtin_amdgcn_rcpf(li_l[crow(r, hi)]);
#pragma unroll
            for (int d0 = 0; d0 < 4; ++d0) o[d0][r] *= rl; }
    }
    float gv[4];
#pragma unroll
    for (int d0 = 0; d0 < 4; ++d0) gv[d0] = gain[d0 * 32 + r32];
#pragma unroll
    for (int r = 0; r < 16; ++r) {
        float ss = (o[0][r] * o[0][r] + o[1][r] * o[1][r]) + (o[2][r] * o[2][r] + o[3][r] * o[3][r]);
        ss += __shfl_xor(ss, 1); ss += __shfl_xor(ss, 2); ss += __shfl_xor(ss, 4); ss += __shfl_xor(ss, 8); ss += __shfl_xor(ss, 16);
        const float rn = __builtin_amdgcn_rsqf(ss * (1.0f / HD) + EPS);
        const int orow = crow(r, hi);
#pragma unroll
        for (int d0 = 0; d0 < 4; ++d0) { const float v = o[d0][r] * rn * gv[d0]; const float vn = __shfl_xor(v, 1);
            if ((r32 & 1) == 0) *(unsigned*)(Mrg + pg8::img_off(grow0 + orow, gcol0 + d0 * 32 + r32, DM)) = cvt_pk_bf16(v, vn); }
    }
}

__device__ __forceinline__ void sb_part1(f32x16& p0, f32x16& p1, float& R, bool diag, int dq, int hi) {
    float sp0[16], sp1[16];
#pragma unroll
    for (int r = 0; r < 16; ++r) { const int c_ = (r & 3) + 8 * (r >> 2);
        float y0 = fminf(p0[r] * C2, 100.f), y1 = fminf(p1[r] * C2, 100.f);
        float s0 = __builtin_amdgcn_logf(1.0f + __builtin_amdgcn_exp2f(y0)), s1 = __builtin_amdgcn_logf(1.0f + __builtin_amdgcn_exp2f(y1));
        sp0[r] = s0; sp1[r] = s1; p0[r] = y0 - s0; p1[r] = y1 - s1; (void)c_; }
    if (diag) {
        asm volatile("; diagonal tile" ::: "memory");
#pragma unroll
        for (int r = 0; r < 16; ++r) { const int c_ = (r & 3) + 8 * (r >> 2);
            if (!(c_ < dq)) { sp0[r] = 0.f; p0[r] = -__builtin_inff(); } if (!(c_ + 32 < dq)) { sp1[r] = 0.f; p1[r] = -__builtin_inff(); } } }
    float G_[8], T_[8];
#pragma unroll
    for (int g = 0; g < 4; ++g) { G_[g] = (sp0[4 * g] + sp0[4 * g + 1]) + (sp0[4 * g + 2] + sp0[4 * g + 3]); G_[4 + g] = (sp1[4 * g] + sp1[4 * g + 1]) + (sp1[4 * g + 2] + sp1[4 * g + 3]); }
    T_[7] = 0.f;
#pragma unroll
    for (int g = 6; g >= 0; --g) T_[g] = T_[g + 1] + G_[g + 1];
    const float tot_ = T_[0] + G_[0];
#pragma unroll
    for (int g = 0; g < 8; ++g) { const float send_ = T_[g] + (hi ? G_[g] : 0.f); T_[g] = R + T_[g] + partner(send_, hi); }
    R += tot_ + partner(tot_, hi);
#pragma unroll
    for (int g = 0; g < 4; ++g) {
        float s3 = T_[g], s2 = s3 + sp0[4 * g + 3], s1_ = s2 + sp0[4 * g + 2], s0_ = s1_ + sp0[4 * g + 1];
        p0[4 * g + 3] -= s3; p0[4 * g + 2] -= s2; p0[4 * g + 1] -= s1_; p0[4 * g] -= s0_;
        s3 = T_[4 + g]; s2 = s3 + sp1[4 * g + 3]; s1_ = s2 + sp1[4 * g + 2]; s0_ = s1_ + sp1[4 * g + 1];
        p1[4 * g + 3] -= s3; p1[4 * g + 2] -= s2; p1[4 * g + 1] -= s1_; p1[4 * g] -= s0_; }
}
__device__ __forceinline__ void sb_finish(f32x16& p0, f32x16& p1, bf16x8& pa0, bf16x8& pa1, bf16x8& pa2, bf16x8& pa3) {
#pragma unroll
    for (int r = 0; r < 16; ++r) { p0[r] = __builtin_amdgcn_exp2f(p0[r]); p1[r] = __builtin_amdgcn_exp2f(p1[r]); }
    pack_p(p0, p1, pa0, pa1, pa2, pa3);
}
__device__ __forceinline__ void fox_part1(f32x16& p0, f32x16& p1, float& m_reg, float& alpha, bool diag, int dq, int hi) {
    if (diag) {
        asm volatile("; diagonal tile" ::: "memory");
#pragma unroll
        for (int r = 0; r < 16; ++r) { const int c_ = (r & 3) + 8 * (r >> 2); if (!(c_ <= dq)) p0[r] = -__builtin_inff(); if (!(c_ + 32 <= dq)) p1[r] = -__builtin_inff(); } }
    float pmax = p0[0];
#pragma unroll
    for (int r = 1; r < 16; ++r) pmax = fmaxf(pmax, p0[r]);
#pragma unroll
    for (int r = 0; r < 16; ++r) pmax = fmaxf(pmax, p1[r]);
    pmax = fmaxf(pmax, partner(pmax, hi));
    if (__all((pmax - m_reg) * SCALE <= 8.0f)) alpha = 1.f;
    else { const float mn = fmaxf(m_reg, pmax); alpha = __builtin_amdgcn_exp2f((m_reg - mn) * C2); m_reg = mn; }
    const float mnL = -m_reg * C2;
#pragma unroll
    for (int r = 0; r < 16; ++r) { p0[r] = fmaf(p0[r], C2, mnL); p1[r] = fmaf(p1[r], C2, mnL); }
#pragma unroll
    for (int r = 0; r < 16; ++r) p0[r] = __builtin_amdgcn_exp2f(p0[r]);
}
__device__ __forceinline__ void fox_finish(f32x16& p0, f32x16& p1, float alpha, float& l_reg, bf16x8& pa0, bf16x8& pa1, bf16x8& pa2, bf16x8& pa3) {
#pragma unroll
    for (int r = 0; r < 16; ++r) p1[r] = __builtin_amdgcn_exp2f(p1[r]);
    float ps = 0.f;
#pragma unroll
    for (int r = 0; r < 16; ++r) ps += p0[r] + p1[r];
    l_reg = l_reg * alpha + ps;
    pack_p(p0, p1, pa0, pa1, pa2, pa3);
}

template <int TYPE>
__device__ __forceinline__ void attn_block(const bf16_t* Qg, const bf16_t* Kg, const bf16_t* Vg, bf16_t* Mrg, int grow_b  , int gcol0  , const float* gain, const float* clr, int P0, LAS unsigned char* lds) {
    const int tid = threadIdx.x, wid = __builtin_amdgcn_readfirstlane(tid >> 6), lane = tid & 63, r32 = lane & 31, hi = lane >> 5;
    const int qlo = P0 + wid * 32, qpos = qlo + r32;
    bf16x8 qr[8];
#pragma unroll
    for (int d0 = 0; d0 < 8; ++d0) qr[d0] = *(const bf16x8*)(Qg + (size_t)qpos * PITCH + d0 * 16 + hi * 8);
    const int NT = P0 / KVBLK + 4;
    const int sr = tid >> 4, sc = (tid & 15) * 8, vst0 = v_st(sr, sc), vst1 = v_st(32 + sr, sc), kws = KSWZ(sr, sc * 2);
    const int vbase = (int)(unsigned)(uintptr_t)lds + v_rd_base(lane);
    LAS volatile int* vote = (LAS volatile int*)(lds + OFF_VOTE);
    LAS const float* CB = (LAS const float*)(lds + OFF_CB);
    LAS const float* KP = (LAS const float*)(lds + OFF_KP);
    LAS float* CLB = (LAS float*)(lds + OFF_CLB);
    LAS float* al_l = (LAS float*)(lds + OFF_WS) + wid * 64 + 32;
    f32x16 o[4];
#pragma unroll
    for (int d0 = 0; d0 < 4; ++d0)
#pragma unroll
        for (int r = 0; r < 16; ++r) o[d0][r] = 0.f;
    float R = 0.f, m_reg = -1e30f, l_reg = 0.f, ctr = 0.f, qn = 0.f;
    if (TYPE == 1) {
        ctr = CB[qpos >> 6] + clr[qpos];
        float s = 0.f;
#pragma unroll
        for (int d0 = 0; d0 < 8; ++d0) { const u32x4 w = __builtin_bit_cast(u32x4, qr[d0]);
#pragma unroll
            for (int j = 0; j < 4; ++j) { const float a = __uint_as_float(w[j] << 16), b = __uint_as_float(w[j] & 0xffff0000u); s = fmaf(a, a, s); s = fmaf(b, b, s); } }
        s += partner(s, hi); qn = sqrtf(s) * 1.01f;
    }
    constexpr int NOPS = (TYPE == 1) ? 5 : 4;
    unsigned koff[2], voff[2];
#pragma unroll
    for (int j = 0; j < 2; ++j) { const int W = wid * 2 + j, row = 4 * W + (lane >> 4), c = (lane & 15) ^ (row & 7); koff[j] = (unsigned)(row * PITCH + c * 8);
        const int sv = 2 * W + (lane >> 5), kk = (sv >> 2) * 8 + ((lane & 31) >> 2), k = (kk & ~0xC) | ((kk & 4) << 1) | ((kk & 8) >> 1); voff[j] = (unsigned)(k * PITCH + (sv & 3) * 32 + (lane & 3) * 8); }
#define DMA_TILE(t_, ks_, vs_) do { const bf16_t* kt_ = Kg + (size_t)(t_) * KVBLK * PITCH; const bf16_t* vt_ = Vg + (size_t)(t_) * KVBLK * PITCH; \
        _Pragma("unroll") for (int j = 0; j < 2; ++j) __builtin_amdgcn_global_load_lds((const unsigned*)(kt_ + koff[j]), (LAS unsigned*)(lds + OFF_K + (ks_) * SHM + (wid * 2 + j) * 1024), 16, 0, 0); \
        _Pragma("unroll") for (int j = 0; j < 2; ++j) __builtin_amdgcn_global_load_lds((const unsigned*)(vt_ + voff[j]), (LAS unsigned*)(lds + (vs_) * SHM + (wid * 2 + j) * 1024), 16, 0, 0); \
        if (TYPE == 1) __builtin_amdgcn_global_load_lds((const unsigned*)(clr + (t_) * KVBLK + lane), (LAS unsigned*)(lds + OFF_CLB + (ks_) * 256), 4, 0, 0); } while (0)
#define WAIT_TILES(n_) asm volatile("s_waitcnt vmcnt(%0)" :: "n"(n_) : "memory")
#define STEP_BAR() do { asm volatile("s_waitcnt lgkmcnt(0)" ::: "memory"); __builtin_amdgcn_s_barrier(); asm volatile("" ::: "memory"); } while (0)
    DMA_TILE(NT - 1, 0, 0); DMA_TILE(NT - 2, 1, 1);
    WAIT_TILES(NOPS); STEP_BAR();
    f32x16 P0r, P1r; bf16x8 pa0, pa1, pa2, pa3;
    int k3 = 0, ilast = 0;
    for (int i = 0;; ++i) {
        const int t_ = NT - 1 - i, kb_ = t_ * KVBLK; const bool more_ = (i + 1 < NT), more2 = (i + 2 < NT);
        const bool actX = (kb_ <= qlo), actY = (i >= 1) && (kb_ + KVBLK <= qlo);
        float dr_ = 0.f;
        if (more2) DMA_TILE(t_ - 2, (k3 == 0 ? 2 : k3 - 1), (i + 2) & 3);
        if (actX) {
            if (TYPE == 1) { dr_ = ctr - CB[t_];
#pragma unroll
                for (int g = 0; g < 4; ++g) { const f32x4 c0 = *(LAS const f32x4*)(CLB + k3 * 64 + 8 * g + 4 * hi), c1 = *(LAS const f32x4*)(CLB + k3 * 64 + 32 + 8 * g + 4 * hi);
#pragma unroll
                    for (int j = 0; j < 4; ++j) { P0r[4 * g + j] = dr_ - c0[j]; P1r[4 * g + j] = dr_ - c1[j]; } } }
            else {
#pragma unroll
                for (int r = 0; r < 16; ++r) { P0r[r] = 0.f; P1r[r] = 0.f; } }
            SBAR(); qkt(P0r, P1r, lds + OFF_K + k3 * SHM, r32, hi, qr); }
        SBAR();
        if (actY) pv_tile(o, vbase + ((i - 1) & 3) * SHM, pa0, pa1, pa2, pa3);
        SBAR();
        bool done_ = false;
        if (actX) {
            if (TYPE == 1) { float alpha_; fox_part1(P0r, P1r, m_reg, alpha_, kb_ + KVBLK - 1 > qlo, qpos - kb_ - 4 * hi, hi);
                if (__any(alpha_ < 1.f)) { if (hi == 0) al_l[r32] = alpha_; asm volatile("s_waitcnt lgkmcnt(0)" ::: "memory");
#pragma unroll
                    for (int r = 0; r < 16; ++r) { const float a_ = al_l[crow(r, hi)];
#pragma unroll
                        for (int d_ = 0; d_ < 4; ++d_) o[d_][r] *= a_; } }
                fox_finish(P0r, P1r, alpha_, l_reg, pa0, pa1, pa2, pa3);
                done_ = (t_ >= 1) && __all(qn * KP[t_ >= 1 ? t_ - 1 : 0] + dr_ - m_reg < -1000.f); }
            else { sb_part1(P0r, P1r, R, kb_ + KVBLK - 1 >= qlo, qpos - kb_ - 4 * hi, hi); sb_finish(P0r, P1r, pa0, pa1, pa2, pa3); done_ = SB_EARLY_EXIT && __all(R > 128.0f); } }
        if (lane == 0) vote[(i & 1) * 8 + wid] = done_ ? 1 : 0;
        if (more2) WAIT_TILES(NOPS); else WAIT_TILES(0);
        STEP_BAR();
        int v_ = 1;
#pragma unroll
        for (int w_ = 0; w_ < 8; ++w_) v_ &= vote[(i & 1) * 8 + w_];
        if (v_ != 0 || !more_) { ilast = i; break; }
        k3 = (k3 == 2) ? 0 : k3 + 1;
    }
    if ((NT - 1 - ilast) * KVBLK <= qlo) pv_tile(o, vbase + (ilast & 3) * SHM, pa0, pa1, pa2, pa3);
    WAIT_TILES(0);
#undef DMA_TILE
#undef WAIT_TILES
#undef STEP_BAR
    head_epilogue<TYPE == 1>(o, l_reg, lds, wid, r32, hi, gain, Mrg, grow_b + qlo, gcol0);
    __syncthreads();
}
}

constexpr size_t MiB = 1u << 20;
constexpr size_t WS_CTL = 0, CTL_ZERO_BYTES = 2 * MiB;
constexpr size_t WS_WGU1 = 2 * MiB;
constexpr size_t WS_WD1 = WS_WGU1 + 172 * MiB;
constexpr size_t WS_WIN = WS_WD1 + 86 * MiB;
constexpr size_t WS_WF = WS_WIN + 96 * MiB;
constexpr size_t WS_WO = WS_WF + 1 * MiB;
constexpr size_t WS_WGU2 = WS_WO + 32 * MiB;
constexpr size_t WS_WD2 = WS_WGU2 + 172 * MiB;
constexpr size_t WS_AB = WS_WD2 + 86 * MiB;
constexpr size_t WS_MRG = WS_AB + 128 * MiB;
constexpr size_t WS_BIG = WS_MRG + 128 * MiB;
constexpr size_t WS_CL = WS_BIG + 384 * MiB;
constexpr size_t WS_CT = WS_CL + 1 * MiB;
constexpr size_t WS_END = WS_CT + 1 * MiB;
static_assert((size_t)2 * DFF * DM * 2 <= 172 * MiB && (size_t)DM * DFF * 2 <= 86 * MiB && (size_t)NQKV * DM * 2 <= 96 * MiB && (size_t)M * DFF * 2 <= 384 * MiB && (size_t)6 * M * GW * 2 <= 384 * MiB, "ws map");
constexpr int CW_BAR = 4096;
constexpr int CW_PNL = 12288;
constexpr int CW_GQ = 32768;
constexpr int CW_CONV = 16384 + 4096;
constexpr int CW_Q = 8192;
constexpr size_t CTL_RSS = 1 * MiB;

constexpr int RING_BYTES = 131072, LDSCTL_OFF = RING_BYTES, MISC_OFF = LDSCTL_OFF + 320, LDS_BYTES = 147456;
static_assert(att::ATT_LDS_BYTES <= RING_BYTES, "attention scratch inside the ring");

#define XB_TMO      128
#define XB_XCNT(j)  (256  + 64 * (j))
#define XB_XSUB(j)  (1280 + 64 * (j))
#define XB_XGEN(j)  (2304 + 64 * (j))
#define XB_TOP      3328
#define XB_TOPGEN   3392
#define XCD_BAR_WORDS 3456
#define XB_SPIN_CAP (1u << 18)
__device__ __forceinline__ unsigned xb_ld(unsigned* p)              { return __hip_atomic_load(p, __ATOMIC_RELAXED, __HIP_MEMORY_SCOPE_AGENT); }
__device__ __forceinline__ unsigned xb_add(unsigned* p, unsigned v) { return __hip_atomic_fetch_add(p, v, __ATOMIC_RELAXED, __HIP_MEMORY_SCOPE_AGENT); }
__device__ __forceinline__ unsigned xb_xcc_id() { return (unsigned)__builtin_amdgcn_s_getreg((3 << 11) | 20) & 0xFu; }
#define XB_SPIN(cond, bar) do { unsigned _sp = 0; while (cond) { __builtin_amdgcn_s_sleep(1); \
    if ((++_sp & 255u) == 0u) { if (xb_ld(&(bar)[XB_TMO])) break; if (_sp > XB_SPIN_CAP) { atomicAdd(&(bar)[XB_TMO], 1u); break; } } } } while (0)
struct XcdBarrier { unsigned* bar; unsigned x; volatile LAS unsigned* st; };
__device__ __forceinline__ XcdBarrier xcd_barrier_post(unsigned* bar, volatile LAS unsigned* st) {
    XcdBarrier b; b.bar = bar; b.x = xb_xcc_id(); b.st = st;
    if (threadIdx.x == 0) (void)xb_add(&bar[XB_XCNT(b.x)], 1u);
    return b;
}
__device__ __forceinline__ void xcd_barrier_complete(unsigned* bar, unsigned x, unsigned& nloc, unsigned& nx) {
    const unsigned G = gridDim.x * gridDim.y * gridDim.z;
    unsigned sum, cnt, mine, sp = 0u;
    for (;;) {
        sum = 0u; cnt = 0u; mine = 0u;
#pragma unroll
        for (unsigned j = 0; j < 16; ++j) { const unsigned c = xb_ld(&bar[XB_XCNT(j)]); sum += c; cnt += (c > 0u) ? 1u : 0u; mine = (j == x) ? c : mine; }
        if (sum == G) break;
        __builtin_amdgcn_s_sleep(1);
        if ((++sp & 255u) == 0u) { if (xb_ld(&bar[XB_TMO])) break; if (sp > XB_SPIN_CAP) { atomicAdd(&bar[XB_TMO], 1u); break; } }
    }
    nloc = mine > 0u ? mine : 1u; nx = cnt > 0u ? cnt : 1u;
}
__device__ __forceinline__ void xcd_barrier(const XcdBarrier& b) {
    asm volatile("s_waitcnt vmcnt(0)" ::: "memory");
    __syncthreads();
    if (threadIdx.x == 0) {
        unsigned* bar = b.bar;
        __builtin_amdgcn_s_waitcnt(0);
        unsigned nloc = b.st[0], nx = b.st[1];
        if (nloc == 0u) { xcd_barrier_complete(bar, b.x, nloc, nx); b.st[0] = nloc; b.st[1] = nx; }
        const unsigned old = xb_add(&bar[XB_XSUB(b.x)], 1u);
        const unsigned gen = old / nloc;
        if (old + 1u == (gen + 1u) * nloc) {
            __builtin_amdgcn_fence(__ATOMIC_RELEASE, "agent");
            asm volatile("s_waitcnt vmcnt(0)" ::: "memory");
            const unsigned og = xb_add(&bar[XB_TOP], 1u);
            const unsigned tg = og / nx;
            if (og + 1u == (tg + 1u) * nx) xb_add(&bar[XB_TOPGEN], 1u);
            else XB_SPIN(xb_ld(&bar[XB_TOPGEN]) == tg, bar);
            __builtin_amdgcn_fence(__ATOMIC_ACQUIRE, "agent");
            xb_add(&bar[XB_XGEN(b.x)], 1u);
            asm volatile("s_waitcnt vmcnt(0)" ::: "memory");
        } else {
            XB_SPIN(xb_ld(&bar[XB_XGEN(b.x)]) == gen, bar);
            __builtin_amdgcn_fence(__ATOMIC_ACQUIRE, "agent");
            asm volatile("s_waitcnt vmcnt(0)" ::: "memory");
        }
    }
    __syncthreads();
}

__device__ __forceinline__ unsigned f2bf(float f) { unsigned u = __builtin_bit_cast(unsigned, f); return (u + 0x7fffu + ((u >> 16) & 1u)) >> 16; }
__device__ __forceinline__ unsigned pk2(float lo, float hi) { return f2bf(lo) | (f2bf(hi) << 16); }
__device__ __forceinline__ float wave_sum(float v) {
#pragma unroll
    for (int o = 1; o < 64; o <<= 1) v += __shfl_xor(v, o);
    return v;
}
__device__ __forceinline__ void tr_item(const float* W, int ldw, int K, int k0, int n0, int nvalid, const float* gain, bf16_t* WT, int orow0, LAS float* scr, int lane, bool image = true) {
    const int nl = lane & 31; const bool ok = nl < nvalid;
    float v[32];
#pragma unroll
    for (int i = 0; i < 32; ++i) { const int kk = 2 * i + (lane >> 5); v[i] = ok ? __builtin_nontemporal_load(W + (size_t)(k0 + kk) * ldw + n0 + nl) : 0.f; }
    if (gain) {
#pragma unroll
        for (int i = 0; i < 32; ++i) { const int kk = 2 * i + (lane >> 5); v[i] *= gain[k0 + kk]; } }
#pragma unroll
    for (int i = 0; i < 32; ++i) { const int kk = 2 * i + (lane >> 5); scr[kk * 33 + nl] = v[i]; }
    asm volatile("s_waitcnt lgkmcnt(0)" ::: "memory");
    const int c = lane & 7;
#pragma unroll
    for (int j = 0; j < 4; ++j) { const int n = (lane >> 3) + 8 * j; const LAS float* s = scr + (8 * c) * 33 + n;
        u32x4 o; o.x = pk2(s[0 * 33], s[1 * 33]); o.y = pk2(s[2 * 33], s[3 * 33]); o.z = pk2(s[4 * 33], s[5 * 33]); o.w = pk2(s[6 * 33], s[7 * 33]);
        if (n < nvalid) *(u32x4*)(WT + (image ? pg8::img_off_b(orow0 + n, k0 + 8 * c, K) : (size_t)(orow0 + n) * K + k0 + 8 * c)) = o; }
    asm volatile("s_waitcnt lgkmcnt(0)" ::: "memory");
}

struct Args { const float* in[16]; float* out; unsigned char* ws; int ph_lo, ph_hi, flag, pad; };
constexpr int NPH = 9;

__global__ void __launch_bounds__(512, 2) mk_fwd(Args args) {
    extern __shared__ __attribute__((aligned(16))) unsigned char lds_raw[];
    LAS unsigned char* lds = (LAS unsigned char*)lds_raw;
    volatile LAS unsigned* MISC = (volatile LAS unsigned*)(lds + MISC_OFF);
    const int tid = threadIdx.x, lane = tid & 63, wave = __builtin_amdgcn_readfirstlane(tid >> 6);
    const int G = gridDim.x, bx = blockIdx.x;
    const int vcu = (G % 8 == 0) ? (bx % 8) * (G / 8) + bx / 8 : bx;
    unsigned char* ws = args.ws;
    unsigned* ctl = (unsigned*)(ws + WS_CTL);
    const float* x = args.in[0]; const float* g_ffn1 = args.in[1]; const float* w_gate1 = args.in[2]; const float* w_up1 = args.in[3]; const float* w_down1 = args.in[4];
    const float* g_mix = args.in[5]; const float* w_in = args.in[6]; const float* b_f = args.in[7]; const float* g_sb = args.in[8]; const float* g_fox = args.in[9];
    const float* w_o = args.in[10]; const float* g_ffn2 = args.in[11]; const float* w_gate2 = args.in[12]; const float* w_up2 = args.in[13]; const float* w_down2 = args.in[14];
    const float* g_fin = args.in[15];
    float* out = args.out;
    bf16_t* Wgu1 = (bf16_t*)(ws + WS_WGU1); bf16_t* Wd1 = (bf16_t*)(ws + WS_WD1); bf16_t* Win = (bf16_t*)(ws + WS_WIN); bf16_t* Wf = (bf16_t*)(ws + WS_WF);
    bf16_t* Wo = (bf16_t*)(ws + WS_WO); bf16_t* Wgu2 = (bf16_t*)(ws + WS_WGU2); bf16_t* Wd2 = (bf16_t*)(ws + WS_WD2);
    bf16_t* AB = (bf16_t*)(ws + WS_AB); bf16_t* MRG = (bf16_t*)(ws + WS_MRG); bf16_t* BIG = (bf16_t*)(ws + WS_BIG);
    float* CL = (float*)(ws + WS_CL); float* CT = (float*)(ws + WS_CT);
    float* rss0 = (float*)(ws + CTL_RSS); float* rss1 = rss0 + M; float* rss2 = rss1 + M; float* rss3 = rss2 + M; float* tmx = rss3 + M;

    for (int u = tid; u < (LDS_BYTES - LDSCTL_OFF) / 4; u += 512) ((LAS unsigned*)(lds + LDSCTL_OFF))[u] = 0u;
    __syncthreads();
    XcdBarrier bar; bar.bar = ctl + CW_BAR; bar.x = 0; bar.st = nullptr;
    if (MK_N_LAUNCHES == 1) bar = xcd_barrier_post(ctl + CW_BAR, MISC + 8);
    const int lo = args.ph_lo, hi_ph = args.ph_hi;
#define IN(k) (lo <= (k) && (k) < hi_ph)
#define SEAM(k) do { if (IN(k) && IN((k) + 1)) xcd_barrier(bar); } while (0)

    constexpr int CV_KB_D = DM / 64, CV_KB_F = DFF / 64, CV_NB_F = DFF / 32, CV_NB_D = DM / 32, CV_NB_Q = NQKV / 32;
    constexpr int CV_I_G = CV_KB_D * CV_NB_F, CV_I_DN = CV_KB_F * CV_NB_D, CV_I_IN = CV_KB_D * (CV_NB_Q + 1), CV_I_O = CV_KB_D * CV_NB_D;
    constexpr int CV_GU2 = 2 * CV_I_G, CV_DN1 = 4 * CV_I_G, CV_DN2 = CV_DN1 + CV_I_DN, CV_IN = CV_DN2 + CV_I_DN, CV_O = CV_IN + CV_I_IN;
    constexpr int CV_BATCH = 4;
#define CONV_TAIL(k_, lo_, n_) do { \
        constexpr int KB_D = CV_KB_D, KB_F = CV_KB_F, NB_F = CV_NB_F, NB_D = CV_NB_D, NB_Q = CV_NB_Q, I_G = CV_I_G, I_DN = CV_I_DN, I_IN = CV_I_IN; \
        (void)KB_D; (void)KB_F; \
        LAS float* scr = (LAS float*)(lds + wave * 16384); \
        volatile LAS int* cslot_ = (volatile LAS int*)(lds + LDS_BYTES - 32); \
        for (;;) { if (tid == 0) *cslot_ = (int)xb_add(ctl + CW_CONV + 64 * (k_), (unsigned)(8 * CV_BATCH)); \
            __syncthreads(); const int base_ = __builtin_amdgcn_readfirstlane(*cslot_); __syncthreads(); \
            if (base_ >= (n_)) break; \
            for (int i_ = 0; i_ < CV_BATCH; ++i_) { const int it_ = base_ + i_ * 8 + wave; if (it_ < (n_)) CONV_ITEM((lo_) + it_); } } \
    } while (0)

    if (IN(0)) {
        LAS float* scr = (LAS float*)(lds + wave * 16384);
        const int gw = vcu * 8 + wave, NGW = G * 8;
        constexpr int KB_D = DM / 64, KB_F = DFF / 64;
        constexpr int NB_F = DFF / 32, NB_D = DM / 32, NB_Q = NQKV / 32;
        constexpr int I_G = KB_D * NB_F, I_DN = KB_F * NB_D, I_IN = KB_D * (NB_Q + 1), I_O = KB_D * NB_D;
        constexpr int NITEMS = 4 * I_G + 2 * I_DN + I_IN + I_O;
#define CONV_ITEM(it_) do { const int it = (it_); \
            int r = it; \
            if (r < 4 * I_G) { \
                const int which = r / I_G; r -= which * I_G; const int kb = r / NB_F, nb = r % NB_F, n0 = nb * 32; \
                const float* W = which == 0 ? w_gate1 : which == 1 ? w_up1 : which == 2 ? w_gate2 : w_up2; \
                bf16_t* WT = which < 2 ? Wgu1 : Wgu2; const float* gn = which < 2 ? g_ffn1 : g_ffn2; \
                const int orow0 = (n0 >> 7) * 256 + (which & 1) * 128 + (n0 & 127); \
                tr_item(W, DFF, DM, kb * 64, n0, 32, gn, WT, orow0, scr, lane); break; } \
            r -= 4 * I_G; \
            if (r < 2 * I_DN) { \
                const int which = r / I_DN; r -= which * I_DN; const int kb = r / NB_D, nb = r % NB_D; \
                tr_item(which ? w_down2 : w_down1, DM, DFF, kb * 64, nb * 32, 32, nullptr, which ? Wd2 : Wd1, nb * 32, scr, lane); break; } \
            r -= 2 * I_DN; \
            if (r < I_IN) { \
                const int kb = r / (NB_Q + 1), nb = r % (NB_Q + 1); \
                if (nb < NB_Q) tr_item(w_in, IN_PROJ, DM, kb * 64, nb * 32, 32, g_mix, Win, nb * 32, scr, lane); \
                else tr_item(w_in, IN_PROJ, DM, kb * 64, NQKV, 16, g_mix, Wf, 0, scr, lane, false); \
                break; } \
            r -= I_IN; \
            { const int kb = r / NB_D, nb = r % NB_D; tr_item(w_o, DM, DM, kb * 64, nb * 32, 32, nullptr, Wo, nb * 32, scr, lane); } \
        } while (0)
        (void)NITEMS;
        for (int j = gw; j < 2 * I_G; j += NGW) CONV_ITEM(j);
        for (int m = gw; m < M; m += NGW) {
            const f32x4* xr = (const f32x4*)(x + (size_t)m * DM) + lane; float ss = 0.f; f32x4 v[16];
#pragma unroll
            for (int j = 0; j < 16; ++j) { v[j] = __builtin_nontemporal_load(xr + 64 * j); ss += (v[j][0] * v[j][0] + v[j][1] * v[j][1]) + (v[j][2] * v[j][2] + v[j][3] * v[j][3]); }
            ss = wave_sum(ss);
            if (lane == 0) rss0[m] = ss;
#pragma unroll
            for (int j = 0; j < 16; ++j) { u32x2 w; w.x = cvt_pk_bf16(v[j][0], v[j][1]); w.y = cvt_pk_bf16(v[j][2], v[j][3]); *(u32x2*)(AB + pg8::img_off(m, 4 * (lane + 64 * j), DM)) = w; }
        }
    }
    SEAM(0);

    if (IN(1)) {
        pg8::Gemm g{AB, Wgu1, M, 2 * DFF, DM}; pg8::DynOrder S{ctl + CW_GQ, 8 * (2 * DFF / pg8::BM), (int)(xb_xcc_id() & 7u), (volatile LAS int*)(lds + LDS_BYTES - 64)};
        pg8::EpiSwiglu E{BIG, rss0};
        pg8::gemm_phase<pg8::EpiSwiglu, pg8::DynOrder, true, true>(lds, g, S, E);
        CONV_TAIL(0, CV_DN1, CV_I_DN);
    }
    SEAM(1);
    if (IN(2)) {
        pg8::Gemm g{BIG, Wd1, M, DM, DFF}; pg8::StaticOrder S; S.init(M, DM, G, bx, 2);
        pg8::EpiResid<true, false> E{AB, AB, rss1, 0.5f};
        pg8::gemm_phase<pg8::EpiResid<true, false>, pg8::StaticOrder, true, true>(lds, g, S, E);
        CONV_TAIL(1, CV_IN, CV_I_IN);
    }
    SEAM(2);
    if (IN(3)) {
        {
        pg8::Gemm g{AB, Win, M, NQKV, DM}; pg8::DynOrder S{ctl + CW_GQ + 512, 8 * (NQKV / pg8::BM), (int)(xb_xcc_id() & 7u), (volatile LAS int*)(lds + LDS_BYTES - 64)};
        pg8::EpiQKV E{BIG, rss1, tmx};
        pg8::gemm_phase<pg8::EpiQKV, pg8::DynOrder, true, true>(lds, g, S, E);
        }
        LAS float* lf = (LAS float*)lds;
        for (int ch = vcu; ch < M / 64; ch += G) {
            if (wave < 4) {
                const int fr = lane & 15, fq = lane >> 4; const int rowA = ch * 64 + wave * 16 + fr;
                const bf16_t* bp = Wf + (size_t)fr * DM + fq * 8;
                f32x4 acc = {0.f, 0.f, 0.f, 0.f};
#pragma unroll 8
                for (int k0 = 0; k0 < DM; k0 += 32) acc = __builtin_amdgcn_mfma_f32_16x16x32_bf16(*(const bf16x8*)(AB + pg8::img_off(rowA, k0 + fq * 8, DM)), *(const bf16x8*)(bp + k0), acc, 0, 0, 0);
                const float bias = b_f[fr];
#pragma unroll
                for (int j = 0; j < 4; ++j) { const int rl = wave * 16 + fq * 4 + j; const float r = rstd_of(ld_agent_f32(rss1 + ch * 64 + rl));
                    const float v = acc[j] * r + bias; const float ls = fminf(v, 0.f) - log1pf(expf(-fabsf(v))); lf[rl * 16 + fr] = ls; }
            }
            __syncthreads();
            if (tid < 16) { const int b = (ch * 64) / SEQ, s0 = (ch * 64) % SEQ; float run = 0.f; float* clp = CL + ((size_t)(b * NH + tid)) * SEQ + s0;
                for (int r = 0; r < 64; ++r) { run += lf[r * 16 + tid]; clp[r] = run * (1.0f / att::SCALE); }
                CT[(b * NH + tid) * 128 + (s0 >> 6)] = run * (1.0f / att::SCALE); }
            __syncthreads();
        }
        CONV_TAIL(5, CV_GU2, CV_I_G);
    }
    SEAM(3);
    if (IN(4)) {
        const size_t TS = (size_t)M * GW;
        const int myq = (int)(xb_xcc_id() & 7u);
        volatile LAS int* slot = (volatile LAS int*)(lds + att::OFF_SLOT);
        unsigned* qf = ctl + CW_Q + args.flag * 1024; unsigned* qs = qf + 8 * 64;
        int last_bh = -1;
        volatile LAS int* hp = (volatile LAS int*)(lds + LDS_BYTES - 256);
        if (tid < 16) { const float mine = b_f[tid]; int rk = 0;
            for (int u = 0; u < 16; ++u) { const float o_ = b_f[u]; rk += (o_ > mine || (o_ == mine && u < tid)) ? 1 : 0; }
            hp[rk] = tid; }
        __syncthreads();
        for (;;) {
            if (tid == 0) { int res = -1; for (int k = 0; k < 8; ++k) { const int q = (myq + k) & 7; const unsigned idx = xb_add(qf + 64 * q, 1u); if (idx < 128u) { res = q * 128 + (int)idx; break; } } *slot = res; }
            __syncthreads(); const int it = *slot; __syncthreads();
            if (it < 0) break;
            const int q = it >> 7, j = it & 127, sl = j >> 5, qb = 31 - (j & 31), b = sl & 1, h = __builtin_amdgcn_readfirstlane(hp[sl < 2 ? q : 15 - q]), bh = b * 16 + h;
            const size_t base = (size_t)b * SEQ * GW + (size_t)h * HD;
            if (bh != last_bh) {
                if (wave == 0) {
                    const float* ct = CT + bh * 128; const float v0 = ct[2 * lane], v1 = ct[2 * lane + 1]; const float s = v0 + v1; float inc = s;
#pragma unroll
                    for (int o = 1; o < 64; o <<= 1) { const float tq = __shfl_up(inc, o); if (lane >= o) inc += tq; }
                    const float ex = inc - s; LAS float* CBw = (LAS float*)(lds + att::OFF_CB); CBw[2 * lane] = ex; CBw[2 * lane + 1] = ex + v0; }
                if (wave == 1) {
                    const float v0 = sqrtf(ld_agent_f32(tmx + bh * 128 + 2 * lane)) * 1.01f, v1 = sqrtf(ld_agent_f32(tmx + bh * 128 + 2 * lane + 1)) * 1.01f; float inc = fmaxf(v0, v1);
#pragma unroll
                    for (int o = 1; o < 64; o <<= 1) { const float tq = __shfl_up(inc, o); if (lane >= o) inc = fmaxf(inc, tq); }
                    float ex = __shfl_up(inc, 1); if (lane == 0) ex = 0.f;
                    LAS float* KPw = (LAS float*)(lds + att::OFF_KP); KPw[2 * lane] = fmaxf(ex, v0); KPw[2 * lane + 1] = inc; }
                __syncthreads(); last_bh = bh;
            }
            att::attn_block<1>(BIG + 3 * TS + base, BIG + 4 * TS + base, BIG + 5 * TS + base, MRG, b * SEQ, GW + h * HD, g_fox + h * HD,
                               CL + (size_t)bh * SEQ, qb * att::QB, lds);
        }
        for (;;) {
            if (tid == 0) { int res = -1; for (int k = 0; k < 8; ++k) { const int q = (myq + k) & 7; const unsigned idx = xb_add(qs + 64 * q, 1u); if (idx < 128u) { res = q * 128 + (int)idx; break; } } *slot = res; }
            __syncthreads(); const int it = *slot; __syncthreads();
            if (it < 0) break;
            const int q = it >> 7, j = it & 127, bh = (j >> 5) * 8 + q, qb = 31 - (j & 31), b = bh >> 4, h = bh & 15;
            const size_t base = (size_t)b * SEQ * GW + (size_t)h * HD;
            att::attn_block<0>(BIG + base, BIG + TS + base, BIG + 2 * TS + base, MRG, b * SEQ, h * HD, g_sb + h * HD, nullptr, qb * att::QB, lds);
        }
        CONV_TAIL(2, CV_O, CV_I_O);
    }
    SEAM(4);
    if (IN(5)) {
        pg8::Gemm g{MRG, Wo, M, DM, DM}; pg8::StaticOrder S; S.init(M, DM, G, bx, 2);
        pg8::EpiResid<true, false> E{AB, AB, rss2, 1.0f};
        pg8::gemm_phase<pg8::EpiResid<true, false>, pg8::StaticOrder, true, true>(lds, g, S, E);
        CONV_TAIL(3, CV_GU2 + CV_I_G, CV_I_G);
    }
    SEAM(5);
    if (IN(6)) {
        pg8::Gemm g{AB, Wgu2, M, 2 * DFF, DM}; pg8::DynOrder S{ctl + CW_GQ + 1024, 8 * (2 * DFF / pg8::BM), (int)(xb_xcc_id() & 7u), (volatile LAS int*)(lds + LDS_BYTES - 64)};
        pg8::EpiSwiglu E{BIG, rss2};
        pg8::gemm_phase<pg8::EpiSwiglu, pg8::DynOrder, true, true>(lds, g, S, E);
        CONV_TAIL(4, CV_DN2, CV_I_DN);
    }
    SEAM(6);
    if (IN(7)) {
        pg8::Gemm g{BIG, Wd2, M, DM, DFF}; pg8::StaticOrder S; S.init(M, DM, G, bx, 2);
        if (G == 256) {
            pg8::EpiResidNorm E{AB, out, rss3, ctl + CW_PNL, g_fin, 0.5f};
            pg8::gemm_phase<pg8::EpiResidNorm, pg8::StaticOrder, true, true>(lds, g, S, E);
        } else {
            pg8::EpiResid<true, true> E{AB, out, rss3, 0.5f};
            pg8::gemm_phase<pg8::EpiResid<true, true>, pg8::StaticOrder, true, true>(lds, g, S, E);
        }
    }
    if (G != 256) SEAM(7);
    if (IN(8) && G != 256) {
        const int gw = vcu * 8 + wave, NGW = G * 8;
        for (int m = gw; m < M; m += NGW) {
            const float r = rstd_of(ld_agent_f32(rss3 + m)); f32x4* xr = (f32x4*)(out + (size_t)m * DM) + lane; const f32x4* gr = (const f32x4*)g_fin + lane;
#pragma unroll
            for (int j = 0; j < 16; ++j) { const f32x4 v = xr[64 * j] * r * gr[64 * j]; xr[64 * j] = v; }
        }
    }
#undef IN
#undef SEAM
#undef CONV_ITEM
#undef CONV_TAIL
}

extern "C" void kernel_launch(void* const* d_in, const int* in_sizes, int n_in, void* d_out, int out_size, void* d_ws, size_t ws_size, hipStream_t stream) {
    static int grid = 0;
    if (grid == 0) {
        if (n_in != 16 || in_sizes[0] != M * DM || out_size != M * DM || ws_size < WS_END + MiB) {
            fprintf(stderr, "kernel_launch: shape/workspace mismatch (n_in %d in0 %d out %d ws %zu need %zu); nothing launched\n", n_in, n_in > 0 ? in_sizes[0] : -1, out_size, ws_size, (size_t)WS_END); grid = -1; return; }
        int dev = 0, cus = 0, per_cu = 0;
        if (hipGetDevice(&dev) != hipSuccess || hipDeviceGetAttribute(&cus, hipDeviceAttributeMultiprocessorCount, dev) != hipSuccess) { fprintf(stderr, "kernel_launch: device query failed\n"); grid = -1; return; }
        if (hipFuncSetAttribute((const void*)mk_fwd, hipFuncAttributeMaxDynamicSharedMemorySize, LDS_BYTES) != hipSuccess) { fprintf(stderr, "kernel_launch: hipFuncSetAttribute failed\n"); grid = -1; return; }
        if (hipOccupancyMaxActiveBlocksPerMultiprocessor(&per_cu, (const void*)mk_fwd, 512, LDS_BYTES) != hipSuccess || per_cu < 1)
            fprintf(stderr, "kernel_launch: note: occupancy query reports %d workgroups per CU\n", per_cu);
        (void)hipGetLastError();
        grid = cus;
    }
    if (grid < 0) return;
    (void)hipMemsetAsync((char*)d_ws + WS_CTL, 0, CTL_ZERO_BYTES, stream);
    Args a{};
    for (int i = 0; i < 16; ++i) a.in[i] = (const float*)d_in[i];
    a.out = (float*)d_out; a.ws = (unsigned char*)d_ws;
    if (MK_N_LAUNCHES == 1) { a.ph_lo = 0; a.ph_hi = NPH; hipLaunchKernelGGL(mk_fwd, dim3(grid), dim3(512), LDS_BYTES, stream, a); }
    else for (int p = 0; p < NPH; ++p) { a.ph_lo = p; a.ph_hi = p + 1; for (int rep = 0; rep < (p == PROBE_REP ? 2 : 1); ++rep) { a.flag = rep; hipLaunchKernelGGL(mk_fwd, dim3(grid), dim3(512), LDS_BYTES, stream, a); } }
    const hipError_t le = hipPeekAtLastError();
    if (le != hipSuccess) fprintf(stderr, "kernel_launch: launch failed: %s\n", hipGetErrorName(le));
}
```

```cpp
#include <hip/hip_runtime.h>
#include <cstdio>
#include <cstdint>

#ifndef MK_N_LAUNCHES
#define MK_N_LAUNCHES 1
#endif
#ifndef PROBE_REP
#define PROBE_REP -1
#endif
#ifndef SB_EARLY_EXIT
#define SB_EARLY_EXIT 1
#endif

#define LAS __attribute__((address_space(3)))
#define GAS __attribute__((address_space(1)))
typedef unsigned short bf16_t;
typedef short bf16x8 __attribute__((ext_vector_type(8)));
typedef short s16x4 __attribute__((ext_vector_type(4)));
typedef float f32x4 __attribute__((ext_vector_type(4)));
typedef float f32x16 __attribute__((ext_vector_type(16)));
typedef unsigned u32x4 __attribute__((ext_vector_type(4)));
typedef unsigned u32x2 __attribute__((ext_vector_type(2)));

constexpr int BATCH = 2, SEQ = 8192, DM = 4096, DFF = 11008, M = BATCH * SEQ;
constexpr int NH = 16, HD = 128, GW = NH * HD;
constexpr int NQKV = 6 * GW;
constexpr int IN_PROJ = NQKV + NH;
constexpr float EPS = 1e-6f;
constexpr float L2E = 1.4426950408889634f;

__device__ __forceinline__ unsigned cvt_pk_bf16(float lo, float hi) { unsigned r; asm volatile("v_cvt_pk_bf16_f32 %0, %1, %2" : "=v"(r) : "v"(lo), "v"(hi)); return r; }
__device__ __forceinline__ float ld_agent_f32(const float* p) { return __uint_as_float(__hip_atomic_load((const unsigned*)p, __ATOMIC_RELAXED, __HIP_MEMORY_SCOPE_AGENT)); }
__device__ __forceinline__ float rstd_of(float ss) { return __builtin_amdgcn_rsqf(ss * (1.0f / DM) + EPS); }

namespace pg8 {
constexpr int BM = 256, BK = 64, HALF = 128, HTB = HALF * BK * 2, STAGE_BYTES = 8 * HTB, NXCD = 8, WGM = 8;
__host__ __device__ __forceinline__ int lds_byte(int r, int c) { const int st = (r >> 4) * 2 + (c >> 5), rr = r & 15, cc = c & 31, ob = rr * 64 + cc * 2; return st * 1024 + (ob ^ (((ob >> 9) & 1) << 5)); }
__host__ __device__ __forceinline__ void stage_rc(int b, int& R, int& C) { const int st = b / 1024, sb = b % 1024, swz = sb ^ (((sb >> 9) & 1) << 5); R = (st >> 1) * 16 + swz / 64; C = (st & 1) * 32 + (swz % 64) / 2; }
__host__ __device__ __forceinline__ int perm32(int rho) { const int n = rho >> 4, i = rho & 15; return 8 * (i >> 2) + 4 * n + (i & 3); }
struct Unit { int pm, pn; };
struct Gemm { const bf16_t* A; const bf16_t* Bt; int M, N, K; };
__host__ __device__ __forceinline__ size_t img_off(int row, int col, int K) { return ((size_t)((row >> 8) * (K >> 6) + (col >> 6)) * 2 + ((row >> 7) & 1)) * 8192 + (size_t)(lds_byte(row & 127, col & 63) >> 1); }
__host__ __device__ __forceinline__ int perm32inv(int w) { return 16 * ((w >> 2) & 1) + 4 * (w >> 3) + (w & 3); }
__host__ __device__ __forceinline__ size_t img_off_b(int n, int k, int K) { return img_off((n & ~31) + perm32inv(n & 31), k, K); }
struct StaticOrder {
    static constexpr bool DYNAMIC = false;
    int nM, nN, nwg, G, c, wgm;
    __host__ __device__ void init(int M_, int N_, int G_, int c_, int wgm_ = WGM) { nM = M_ / BM; nN = N_ / BM; nwg = nM * nN; G = G_; c = c_; wgm = wgm_; }
    __host__ __device__ bool next(int i, Unit& u) const {
        const long L = (long)i * G + c; if (L >= nwg) return false;
        int wgid = (int)L; { const int q = nwg / NXCD, r = nwg % NXCD, xcd = wgid % NXCD, off = wgid / NXCD; wgid = (xcd < r ? xcd * (q + 1) : r * (q + 1) + (xcd - r) * q) + off; }
        const int nig = wgm * nN, gid = wgid / nig, fm = gid * wgm, gsz = (nM - fm) < wgm ? (nM - fm) : wgm;
        u.pm = fm + ((wgid % nig) % gsz); u.pn = (wgid % nig) / gsz; return true;
    }
    __device__ __forceinline__ void a_ready(const Unit&) const {}
    __device__ __forceinline__ void done(const Unit&) const {}
};
struct DynOrder {
    static constexpr bool DYNAMIC = true;
    unsigned* heads; int per, home; volatile LAS int* slot;
    __device__ __forceinline__ void decode(int id, Unit& u) const { const int q = id / per, off = id - q * per; u.pm = 8 * q + (off & 7); u.pn = off >> 3; }
    __device__ __forceinline__ int pop_from(int k0) const {
        for (int k = k0; k < 8; ++k) { const int q = (home + k) & 7; const unsigned off = __hip_atomic_fetch_add(heads + 64 * q, 1u, __ATOMIC_RELAXED, __HIP_MEMORY_SCOPE_AGENT); if (off < (unsigned)per) return q * per + (int)off; }
        return -1;
    }
    __device__ __forceinline__ bool next(int, Unit&) const { return false; }
    __device__ __forceinline__ void a_ready(const Unit&) const {}
    __device__ __forceinline__ void done(const Unit&) const {}
};


using f32x2 = __attribute__((ext_vector_type(2))) float;
struct EpiSwiglu {
    static constexpr bool PERM = true, AFTER_DRAIN = false;
    bf16_t* H; const float* rowss;
    __device__ __forceinline__ void operator()(const f32x4 (&acc)[2][2][4][2], const Unit& u, int wr, int wc, int fr, int fq) const {
        const int row0 = u.pm * BM + wr * 64 + fr, col0 = u.pn * HALF + wc * 32 + 8 * fq;
        float rs[2][4];
#pragma unroll
        for (int ai = 0; ai < 2; ++ai)
#pragma unroll
            for (int m = 0; m < 4; ++m) rs[ai][m] = ld_agent_f32(rowss + row0 + ai * HALF + m * 16);
#pragma unroll
        for (int ai = 0; ai < 2; ++ai)
#pragma unroll
            for (int m = 0; m < 4; ++m) {
                const int row = row0 + ai * HALF + m * 16; const float r = rstd_of(rs[ai][m]);
                const f32x2 rn = {-L2E * r, -L2E * r}, r2 = {r * r, r * r}; f32x2 t[4], p[4];
#pragma unroll
                for (int k = 0; k < 4; ++k) { const f32x2 g = {acc[ai][0][m][k >> 1][2 * (k & 1)], acc[ai][0][m][k >> 1][2 * (k & 1) + 1]}, up = {acc[ai][1][m][k >> 1][2 * (k & 1)], acc[ai][1][m][k >> 1][2 * (k & 1) + 1]};
                    t[k] = g * rn; p[k] = (g * up) * r2; }
#pragma unroll
                for (int k = 0; k < 4; ++k) { t[k].x = __builtin_amdgcn_exp2f(t[k].x); t[k].y = __builtin_amdgcn_exp2f(t[k].y); }
#pragma unroll
                for (int k = 0; k < 4; ++k) t[k] = t[k] + (f32x2){1.0f, 1.0f};
#pragma unroll
                for (int k = 0; k < 4; ++k) { t[k].x = __builtin_amdgcn_rcpf(t[k].x); t[k].y = __builtin_amdgcn_rcpf(t[k].y); }
#pragma unroll
                for (int k = 0; k < 4; ++k) p[k] = p[k] * t[k];
                u32x4 w; w.x = cvt_pk_bf16(p[0].x, p[0].y); w.y = cvt_pk_bf16(p[1].x, p[1].y); w.z = cvt_pk_bf16(p[2].x, p[2].y); w.w = cvt_pk_bf16(p[3].x, p[3].y);
                *(u32x4*)(H + img_off(row, col0, DFF)) = w; }
    }
};
template <bool BASE_BF16, bool OUT_F32>
struct EpiResid {
    static constexpr bool PERM = true, AFTER_DRAIN = false;
    const void* base; void* out; float* rowss; float scale;
    __device__ __forceinline__ void operator()(const f32x4 (&acc)[2][2][4][2], const Unit& u, int wr, int wc, int fr, int fq) const {
        const int row0 = u.pm * BM + wr * 64 + fr, col0 = u.pn * BM + wc * 32 + 8 * fq;
#pragma unroll
        for (int ai = 0; ai < 2; ++ai) {
            f32x4 bv[4][2][2];
#pragma unroll
            for (int m = 0; m < 4; ++m) { const int row = row0 + ai * HALF + m * 16; const size_t off = (size_t)row * DM + col0;
#pragma unroll
                for (int bj = 0; bj < 2; ++bj) {
                    if (BASE_BF16) { const u32x4 w = *(const u32x4*)((const bf16_t*)base + img_off(row, col0 + bj * HALF, DM));
                        bv[m][bj][0] = (f32x4){__uint_as_float(w.x << 16), __uint_as_float(w.x & 0xffff0000u), __uint_as_float(w.y << 16), __uint_as_float(w.y & 0xffff0000u)};
                        bv[m][bj][1] = (f32x4){__uint_as_float(w.z << 16), __uint_as_float(w.z & 0xffff0000u), __uint_as_float(w.w << 16), __uint_as_float(w.w & 0xffff0000u)}; }
                    else { bv[m][bj][0] = *(const f32x4*)((const float*)base + off + bj * HALF); bv[m][bj][1] = *(const f32x4*)((const float*)base + off + bj * HALF + 4); } } }
            asm volatile("" ::: "memory");
#pragma unroll
            for (int m = 0; m < 4; ++m) {
                const int row = row0 + ai * HALF + m * 16; const size_t off = (size_t)row * DM + col0; float ss = 0.f;
#pragma unroll
                for (int bj = 0; bj < 2; ++bj) {
                    const f32x4 v0 = bv[m][bj][0] + acc[ai][bj][m][0] * scale, v1 = bv[m][bj][1] + acc[ai][bj][m][1] * scale;
                    ss += (v0[0] * v0[0] + v0[1] * v0[1]) + (v0[2] * v0[2] + v0[3] * v0[3]) + (v1[0] * v1[0] + v1[1] * v1[1]) + (v1[2] * v1[2] + v1[3] * v1[3]);
                    if (OUT_F32) { *(f32x4*)((float*)out + off + bj * HALF) = v0; *(f32x4*)((float*)out + off + bj * HALF + 4) = v1; }
                    else { u32x4 w; w.x = cvt_pk_bf16(v0[0], v0[1]); w.y = cvt_pk_bf16(v0[2], v0[3]); w.z = cvt_pk_bf16(v1[0], v1[1]); w.w = cvt_pk_bf16(v1[2], v1[3]);
                        *(u32x4*)((bf16_t*)out + img_off(row, col0 + bj * HALF, DM)) = w; } }
                ss += __shfl_xor(ss, 16); ss += __shfl_xor(ss, 32);
                if (fq == 0) __hip_atomic_fetch_add(rowss + row, ss, __ATOMIC_RELAXED, __HIP_MEMORY_SCOPE_AGENT); }
        }
    }
};
struct EpiResidNorm {
    static constexpr bool PERM = true, AFTER_DRAIN = false;
    const bf16_t* base; float* out; float* rowss; unsigned* cnt; const float* gain; float scale;
    __device__ __forceinline__ void operator()(const f32x4 (&acc_c)[2][2][4][2], const Unit& u, int wr, int wc, int fr, int fq) const {
        f32x4 (&acc)[2][2][4][2] = const_cast<f32x4 (&)[2][2][4][2]>(acc_c);
        const int row0 = u.pm * BM + wr * 64 + fr, col0 = u.pn * BM + wc * 32 + 8 * fq;
#pragma unroll
        for (int ai = 0; ai < 2; ++ai) {
            u32x4 bw[4][2];
#pragma unroll
            for (int m = 0; m < 4; ++m) {
#pragma unroll
                for (int bj = 0; bj < 2; ++bj) bw[m][bj] = *(const u32x4*)(base + img_off(row0 + ai * HALF + m * 16, col0 + bj * HALF, DM)); }
#pragma unroll
            for (int m = 0; m < 4; ++m) { float ss = 0.f;
#pragma unroll
                for (int bj = 0; bj < 2; ++bj) { const u32x4 w = bw[m][bj];
                    const f32x4 b0 = {__uint_as_float(w.x << 16), __uint_as_float(w.x & 0xffff0000u), __uint_as_float(w.y << 16), __uint_as_float(w.y & 0xffff0000u)};
                    const f32x4 b1 = {__uint_as_float(w.z << 16), __uint_as_float(w.z & 0xffff0000u), __uint_as_float(w.w << 16), __uint_as_float(w.w & 0xffff0000u)};
                    const f32x4 v0 = b0 + acc[ai][bj][m][0] * scale, v1 = b1 + acc[ai][bj][m][1] * scale; acc[ai][bj][m][0] = v0; acc[ai][bj][m][1] = v1;
                    ss += (v0[0] * v0[0] + v0[1] * v0[1]) + (v0[2] * v0[2] + v0[3] * v0[3]) + (v1[0] * v1[0] + v1[1] * v1[1]) + (v1[2] * v1[2] + v1[3] * v1[3]); }
                ss += __shfl_xor(ss, 16); ss += __shfl_xor(ss, 32);
                if (fq == 0) __hip_atomic_fetch_add(rowss + row0 + ai * HALF + m * 16, ss, __ATOMIC_RELAXED, __HIP_MEMORY_SCOPE_AGENT); }
        }
        asm volatile("s_waitcnt vmcnt(0)" ::: "memory");
        unsigned* pc = cnt + 64 * u.pm;
        if (fr == 0 && fq == 0) __hip_atomic_fetch_add(pc, 1u, __ATOMIC_RELAXED, __HIP_MEMORY_SCOPE_AGENT);
        { unsigned spins = 0;
          while ((unsigned)__builtin_amdgcn_readfirstlane(__hip_atomic_load(pc, __ATOMIC_RELAXED, __HIP_MEMORY_SCOPE_AGENT)) < 128u) { __builtin_amdgcn_s_sleep(2); if (++spins > (1u << 22)) break; } }
        f32x4 g0[2], g1[2];
#pragma unroll
        for (int bj = 0; bj < 2; ++bj) { g0[bj] = *(const f32x4*)(gain + col0 + bj * HALF); g1[bj] = *(const f32x4*)(gain + col0 + bj * HALF + 4); }
        float rs[2][4];
#pragma unroll
        for (int ai = 0; ai < 2; ++ai)
#pragma unroll
            for (int m = 0; m < 4; ++m) rs[ai][m] = ld_agent_f32(rowss + row0 + ai * HALF + m * 16);
#pragma unroll
        for (int ai = 0; ai < 2; ++ai)
#pragma unroll
            for (int m = 0; m < 4; ++m) { const int row = row0 + ai * HALF + m * 16; const float r = rstd_of(rs[ai][m]); float* op = out + (size_t)row * DM + col0;
#pragma unroll
                for (int bj = 0; bj < 2; ++bj) { *(f32x4*)(op + bj * HALF) = acc[ai][bj][m][0] * r * g0[bj]; *(f32x4*)(op + bj * HALF + 4) = acc[ai][bj][m][1] * r * g1[bj]; } }
    }
};
struct EpiQKV {
    static constexpr bool PERM = true, AFTER_DRAIN = false;
    bf16_t* O; const float* rowss; float* tmx;
    __device__ __forceinline__ void operator()(const f32x4 (&acc)[2][2][4][2], const Unit& u, int wr, int wc, int fr, int fq) const {
        const int row0 = u.pm * BM + wr * 64 + fr; const int colt = u.pn * BM, t = colt >> 11, cin = colt & (GW - 1);
        bf16_t* basep = O + (size_t)t * ((size_t)M * GW) + cin + wc * 32 + 8 * fq;
        float rs[2][4];
#pragma unroll
        for (int ai = 0; ai < 2; ++ai)
#pragma unroll
            for (int m = 0; m < 4; ++m) rs[ai][m] = rstd_of(ld_agent_f32(rowss + row0 + ai * HALF + m * 16));
#pragma unroll
        for (int ai = 0; ai < 2; ++ai)
#pragma unroll
            for (int m = 0; m < 4; ++m) {
                const int row = row0 + ai * HALF + m * 16; const float r = rs[ai][m]; bf16_t* rowp = basep + (size_t)row * GW;
#pragma unroll
                for (int bj = 0; bj < 2; ++bj) { const f32x4 v0 = acc[ai][bj][m][0] * r, v1 = acc[ai][bj][m][1] * r;
                    u32x4 w; w.x = cvt_pk_bf16(v0[0], v0[1]); w.y = cvt_pk_bf16(v0[2], v0[3]); w.z = cvt_pk_bf16(v1[0], v1[1]); w.w = cvt_pk_bf16(v1[2], v1[3]);
                    *(u32x4*)(rowp + bj * HALF) = w; } }
        if (t == 4) {
#pragma unroll
            for (int ai = 0; ai < 2; ++ai)
#pragma unroll
                for (int bj = 0; bj < 2; ++bj) {
                    float mx = 0.f;
#pragma unroll
                    for (int m = 0; m < 4; ++m) { const f32x4 v0 = acc[ai][bj][m][0] * rs[ai][m], v1 = acc[ai][bj][m][1] * rs[ai][m];
                        float s = (v0[0] * v0[0] + v0[1] * v0[1]) + (v0[2] * v0[2] + v0[3] * v0[3]) + (v1[0] * v1[0] + v1[1] * v1[1]) + (v1[2] * v1[2] + v1[3] * v1[3]);
                        s += __shfl_xor(s, 16); s += __shfl_xor(s, 32); mx = fmaxf(mx, s); }
                    mx = fmaxf(mx, __shfl_xor(mx, 1)); mx = fmaxf(mx, __shfl_xor(mx, 2)); mx = fmaxf(mx, __shfl_xor(mx, 4)); mx = fmaxf(mx, __shfl_xor(mx, 8));
                    const int rowt = u.pm * BM + ai * HALF + wr * 64, bb = rowt / SEQ, tile = (rowt % SEQ) >> 6, head = (cin >> 7) + bj;
                    if (fr == 0 && fq == 0) __hip_atomic_fetch_add(tmx + (bb * NH + head) * 128 + tile, mx, __ATOMIC_RELAXED, __HIP_MEMORY_SCOPE_AGENT); }
        }
    }
};

template <class Epi, class Sched, bool ALIGN_EPI = false, bool SP2 = false>
__device__ __forceinline__ void gemm_phase(LAS unsigned char* lds, const Gemm g, const Sched& S, const Epi& E) {
    const int tid = threadIdx.x, wid = __builtin_amdgcn_readfirstlane(tid >> 6), lane = tid & 63, wr = wid >> 2, wc = wid & 3, fr = lane & 15, fq = lane >> 4;
    const int K = g.K, nt = K / BK;
    static_assert(Epi::PERM, "the B images are stored with the perm32 row order");
    unsigned voffA[2], voffB[2];
#pragma unroll
    for (int i = 0; i < 2; ++i) { voffA[i] = (unsigned)(tid * 16 + i * 8192); voffB[i] = voffA[i]; }
    const size_t kstep = (size_t)(BM * BK * 2);
    const size_t hstep = (size_t)(HALF * BK * 2);
    const size_t tstep = (size_t)BM * K * 2;
    const unsigned ldsw = (unsigned)wid * 1024u;
    const int aoff = lds_byte(wr * 64 + fr, fq * 8), boff = lds_byte(wc * 32 + fr, fq * 8);
#define PG8_SA(b, h) (((b) * 2 + (h)) * HTB)
#define PG8_SB(b, h) ((4 + (b) * 2 + (h)) * HTB)
    const unsigned ldsbase = (unsigned)__builtin_amdgcn_readfirstlane((int)((unsigned)(uintptr_t)lds + ldsw));
#define PG8_STAGE(bufoff, gbase, voff) do { _Pragma("unroll") for (int _i = 0; _i < 2; ++_i) { \
        asm volatile("s_add_i32 m0, %2, %3\n\ts_nop 0\n\tglobal_load_lds_dwordx4 %0, %1" \
                     :: "v"((voff)[_i]), "s"((const void*)(gbase)), "s"(ldsbase), "n"((bufoff) + _i * 8192) : "memory", "m0", "scc"); } } while (0)
#define PG8_LDA(dst, b, h) do { _Pragma("unroll") for (int m = 0; m < 4; ++m) _Pragma("unroll") for (int k = 0; k < 2; ++k) dst[m][k] = *(const LAS bf16x8*)(lds + PG8_SA(b, h) + aoff + m * 2048 + k * 1024); } while (0)
#define PG8_LDB(dst, b, h) do { _Pragma("unroll") for (int n = 0; n < 2; ++n) _Pragma("unroll") for (int k = 0; k < 2; ++k) dst[n][k] = *(const LAS bf16x8*)(lds + PG8_SB(b, h) + boff + n * 2048 + k * 1024); } while (0)
#define PG8_MMA(ai, bj, At, Bt) do { __builtin_amdgcn_s_setprio(1); _Pragma("unroll") for (int m = 0; m < 4; ++m) _Pragma("unroll") for (int n = 0; n < 2; ++n) _Pragma("unroll") for (int k = 0; k < 2; ++k) \
        acc[ai][bj][m][n] = __builtin_amdgcn_mfma_f32_16x16x32_bf16(Bt[n][k], At[m][k], acc[ai][bj][m][n], 0, 0, 0); __builtin_amdgcn_s_setprio(0); } while (0)
#define PG8_WAIT_V(n) asm volatile("s_waitcnt vmcnt(" #n ")" ::: "memory")
#define PG8_WAIT_L(n) asm volatile("s_waitcnt lgkmcnt(" #n ")" ::: "memory")
#define PG8_BAR __builtin_amdgcn_s_barrier()
#define PG8_SCHED __builtin_amdgcn_sched_barrier(0)
    Unit cur, nxt; int ui = 0;
    if constexpr (Sched::DYNAMIC) {
        if (tid == 0) S.slot[0] = S.pop_from(0);
        __syncthreads();
        const int id0 = S.slot[0]; if (id0 < 0) return;
        S.decode(id0, cur);
    } else { if (!S.next(0, cur)) return; }
    f32x4 acc[2][2][4][2];
#pragma unroll
    for (int a = 0; a < 2; ++a)
#pragma unroll
        for (int b = 0; b < 2; ++b)
#pragma unroll
            for (int m = 0; m < 4; ++m)
#pragma unroll
                for (int n = 0; n < 2; ++n) acc[a][b][m][n] = (f32x4){0.f, 0.f, 0.f, 0.f};
    bf16x8 At[4][2], B0[2][2], B1[2][2];
    const char* cA = (const char*)g.A + (size_t)cur.pm * tstep; const char* cB = (const char*)g.Bt + (size_t)cur.pn * tstep;
    S.a_ready(cur);
    if constexpr (SP2) {
        PG8_STAGE(PG8_SB(0, 0), cB, voffB); PG8_STAGE(PG8_SB(0, 1), cB + hstep, voffB); PG8_STAGE(PG8_SA(0, 0), cA, voffA); PG8_STAGE(PG8_SA(0, 1), cA + hstep, voffA);
        if (wr == 1) PG8_BAR;
        PG8_WAIT_V(2); PG8_BAR;
        PG8_STAGE(PG8_SB(1, 0), cB + kstep, voffB); PG8_STAGE(PG8_SA(1, 0), cA + kstep, voffA); PG8_STAGE(PG8_SB(1, 1), cB + hstep + kstep, voffB);
        PG8_WAIT_V(6); PG8_BAR;
    } else {
        PG8_STAGE(PG8_SB(0, 0), cB, voffB); PG8_STAGE(PG8_SA(0, 0), cA, voffA); PG8_STAGE(PG8_SB(0, 1), cB + hstep, voffB); PG8_STAGE(PG8_SA(0, 1), cA + hstep, voffA);
        if (wr == 1) PG8_BAR;
        PG8_WAIT_V(4); PG8_BAR;
        PG8_STAGE(PG8_SB(1, 0), cB + kstep, voffB); PG8_STAGE(PG8_SA(1, 0), cA + kstep, voffA); PG8_STAGE(PG8_SB(1, 1), cB + hstep + kstep, voffB);
        PG8_WAIT_V(6); PG8_BAR;
    }
    for (;;) {
        bool has_next = false; const char* nA = cA; const char* nB = cB; unsigned popv = 0;
        if constexpr (!Sched::DYNAMIC) { has_next = S.next(ui + 1, nxt); if (has_next) { nA = (const char*)g.A + (size_t)nxt.pm * tstep; nB = (const char*)g.Bt + (size_t)nxt.pn * tstep; } }
        for (int t = 0; t < nt; t += 2) {
            const bool last = (t == nt - 2);
            if constexpr (Sched::DYNAMIC) {
                if (t == nt - 6 && tid == 0) asm volatile("global_atomic_add %0, %1, %2, %3 sc0" : "=v"(popv) : "v"(0u), "v"(1u), "s"(S.heads + 64 * S.home) : "memory");
                if (t == nt - 4 && tid == 0) S.slot[(ui + 1) & 1] = (popv < (unsigned)S.per) ? S.home * S.per + (int)popv : S.pop_from(1);
                if (last) { const int idn = S.slot[(ui + 1) & 1]; has_next = idn >= 0; if (has_next) { S.decode(idn, nxt); nA = (const char*)g.A + (size_t)nxt.pm * tstep; nB = (const char*)g.Bt + (size_t)nxt.pn * tstep; } }
            }
            const char* a1 = cA + (size_t)(t + 1) * kstep;
            const char* a2 = last ? nA : cA + (size_t)(t + 2) * kstep; const char* b2 = last ? nB : cB + (size_t)(t + 2) * kstep;
            const char* a3 = a2 + kstep; const char* b3 = b2 + kstep;
            if (last && has_next) S.a_ready(nxt);
            if constexpr (SP2) {
            PG8_LDB(B0, 0, 0); PG8_LDB(B1, 0, 1); PG8_SCHED; PG8_LDA(At, 0, 0); PG8_STAGE(PG8_SA(1, 1), a1 + hstep, voffA);
            PG8_WAIT_V(8); PG8_WAIT_L(0); PG8_BAR; PG8_MMA(0, 0, At, B0); PG8_MMA(0, 1, At, B1); PG8_BAR; PG8_SCHED;
            PG8_LDA(At, 0, 1); PG8_STAGE(PG8_SB(0, 0), b2, voffB); PG8_STAGE(PG8_SB(0, 1), b2 + hstep, voffB); PG8_STAGE(PG8_SA(0, 0), a2, voffA);
            PG8_WAIT_V(8); PG8_WAIT_L(0); PG8_BAR; PG8_MMA(1, 0, At, B0); PG8_MMA(1, 1, At, B1); PG8_BAR; PG8_SCHED;
            PG8_LDB(B0, 1, 0); PG8_LDB(B1, 1, 1); PG8_SCHED; PG8_LDA(At, 1, 0); PG8_STAGE(PG8_SA(0, 1), a2 + hstep, voffA);
            PG8_WAIT_V(8); PG8_WAIT_L(0); PG8_BAR; PG8_MMA(0, 0, At, B0); PG8_MMA(0, 1, At, B1); PG8_BAR; PG8_SCHED;
            PG8_LDA(At, 1, 1); PG8_STAGE(PG8_SB(1, 0), b3, voffB); PG8_STAGE(PG8_SB(1, 1), b3 + hstep, voffB); PG8_STAGE(PG8_SA(1, 0), a3, voffA);
            PG8_WAIT_V(8); PG8_WAIT_L(0); PG8_BAR; PG8_MMA(1, 0, At, B0); PG8_MMA(1, 1, At, B1); PG8_BAR; PG8_SCHED;
            } else {
            PG8_LDB(B0, 0, 0); PG8_SCHED; PG8_LDA(At, 0, 0); PG8_STAGE(PG8_SA(1, 1), a1 + hstep, voffA);
            PG8_WAIT_L(8); PG8_BAR; PG8_WAIT_L(0); PG8_MMA(0, 0, At, B0); PG8_BAR; PG8_SCHED;
            PG8_LDB(B1, 0, 1); PG8_STAGE(PG8_SB(0, 0), b2, voffB);
            PG8_BAR; PG8_WAIT_L(0); PG8_MMA(0, 1, At, B1); PG8_BAR;
            PG8_LDA(At, 0, 1); PG8_STAGE(PG8_SA(0, 0), a2, voffA);
            PG8_BAR; PG8_WAIT_L(0); PG8_MMA(1, 0, At, B0); PG8_BAR; PG8_SCHED;
            PG8_STAGE(PG8_SB(0, 1), b2 + hstep, voffB);
            PG8_WAIT_V(6); PG8_BAR; PG8_MMA(1, 1, At, B1); PG8_BAR;
            PG8_LDB(B0, 1, 0); PG8_SCHED; PG8_LDA(At, 1, 0); PG8_STAGE(PG8_SA(0, 1), a2 + hstep, voffA);
            PG8_WAIT_L(8); PG8_BAR; PG8_WAIT_L(0); PG8_MMA(0, 0, At, B0); PG8_BAR; PG8_SCHED;
            PG8_LDB(B1, 1, 1); PG8_STAGE(PG8_SB(1, 0), b3, voffB);
            PG8_BAR; PG8_WAIT_L(0); PG8_MMA(0, 1, At, B1); PG8_BAR;
            PG8_LDA(At, 1, 1); PG8_STAGE(PG8_SA(1, 0), a3, voffA);
            PG8_BAR; PG8_WAIT_L(0); PG8_MMA(1, 0, At, B0); PG8_BAR; PG8_SCHED;
            PG8_STAGE(PG8_SB(1, 1), b3 + hstep, voffB);
            PG8_WAIT_V(6); PG8_BAR; PG8_MMA(1, 1, At, B1); PG8_BAR;
            }
        }
        if constexpr (ALIGN_EPI) { if (wr == 0) PG8_BAR; }
        if constexpr (!Epi::AFTER_DRAIN) { E(acc, cur, wr, wc, fr, fq); S.done(cur); }
        if (!has_next) break;
#pragma unroll
        for (int a = 0; a < 2; ++a)
#pragma unroll
            for (int b = 0; b < 2; ++b)
#pragma unroll
                for (int m = 0; m < 4; ++m)
#pragma unroll
                    for (int n = 0; n < 2; ++n) acc[a][b][m][n] = (f32x4){0.f, 0.f, 0.f, 0.f};
        cur = nxt; cA = nA; cB = nB; ++ui;
        if constexpr (ALIGN_EPI) { if (wr == 1) PG8_BAR; }
    }
    PG8_WAIT_V(0);
    if constexpr (!ALIGN_EPI) { if (wr == 0) PG8_BAR; }
    PG8_BAR;
#undef PG8_SA
#undef PG8_SB
#undef PG8_STAGE
#undef PG8_LDA
#undef PG8_LDB
#undef PG8_MMA
#undef PG8_WAIT_V
#undef PG8_WAIT_L
#undef PG8_BAR
#undef PG8_SCHED
}
}

namespace att {
constexpr int PITCH = GW, QB = 256, KVBLK = 64, SHM = 16384;
constexpr float SCALE = 0.08838834764831845f;
constexpr float C2 = SCALE * L2E;
constexpr int OFF_K = 65536, OFF_WS = 114688, OFF_CB = 116736, OFF_KP = 117248, OFF_CLB = 117760, OFF_VOTE = 118528, OFF_SLOT = 118592, ATT_LDS_BYTES = 118592 + 64;
#define KSWZ(row, colB) ((row) * 256 + ((colB) ^ (((row) & 7) << 4)))
#define SBAR() __builtin_amdgcn_sched_barrier(0)
__device__ __forceinline__ int v_st(int k, int c) { const int kk = (k & ~0xC) | ((k & 4) << 1) | ((k & 8) >> 1); return ((kk >> 3) * 4 + (c >> 5)) * 512 + ((kk & 7) * 32 + (c & 31)) * 2; }
__device__ __forceinline__ int v_rd_base(int lane) { return ((lane & 3) << 3) | (((lane >> 2) & 3) << 6) | (((lane >> 4) & 1) << 5) | (((lane >> 5) & 1) << 8); }
constexpr int v_rd_off(int d0, int ks, int half) { return d0 * 512 + ks * 4096 + half * 2048; }
__device__ __forceinline__ int crow(int r, int hi) { return (r & 3) + 8 * (r >> 2) + 4 * hi; }
__device__ __forceinline__ float partner(float x, int hi) { auto rr = __builtin_amdgcn_permlane32_swap(__float_as_uint(x), __float_as_uint(x), false, false); return __uint_as_float(hi ? rr[0] : rr[1]); }

__device__ __forceinline__ void qkt(f32x16& p0, f32x16& p1, LAS const unsigned char* Kt, int r32, int hi, const bf16x8* qr) {
    LAS const unsigned char* kb[4];
#pragma unroll
    for (int dd = 0; dd < 4; ++dd) kb[dd] = Kt + KSWZ(r32, (dd * 16 + hi * 8) * 2);
#pragma unroll
    for (int d0 = 0; d0 < 8; ++d0) { LAS const unsigned char* a = kb[d0 & 3] + (d0 >> 2) * 128;
        const bf16x8 b0 = *(LAS const bf16x8*)a;
        const bf16x8 b1 = *(LAS const bf16x8*)(a + 32 * 256);
        p0 = __builtin_amdgcn_mfma_f32_32x32x16_bf16(b0, qr[d0], p0, 0, 0, 0);
        p1 = __builtin_amdgcn_mfma_f32_32x32x16_bf16(b1, qr[d0], p1, 0, 0, 0); }
}
__device__ __forceinline__ void pv_tile(f32x16* o, int vb0, bf16x8 pa0, bf16x8 pa1, bf16x8 pa2, bf16x8 pa3) {
#define TRRD(dst, off) asm volatile("ds_read_b64_tr_b16 %0, %1 offset:%2" : "=&v"(dst) : "v"(vb0), "i"(off) : "memory")
#define PV_D0(d0) do { s16x4 l0, l1, l2, l3, h0, h1, h2, h3; constexpr int b_ = v_rd_off(d0, 0, 0); \
        TRRD(l0, b_); TRRD(h0, b_ + 2048); TRRD(l1, b_ + 4096); TRRD(h1, b_ + 6144); TRRD(l2, b_ + 8192); TRRD(h2, b_ + 10240); TRRD(l3, b_ + 12288); TRRD(h3, b_ + 14336); \
        asm volatile("s_waitcnt lgkmcnt(0)" ::: "memory"); SBAR(); \
        o[d0] = __builtin_amdgcn_mfma_f32_32x32x16_bf16(pa0, (bf16x8){l0[0], l0[1], l0[2], l0[3], h0[0], h0[1], h0[2], h0[3]}, o[d0], 0, 0, 0); \
        o[d0] = __builtin_amdgcn_mfma_f32_32x32x16_bf16(pa1, (bf16x8){l1[0], l1[1], l1[2], l1[3], h1[0], h1[1], h1[2], h1[3]}, o[d0], 0, 0, 0); \
        o[d0] = __builtin_amdgcn_mfma_f32_32x32x16_bf16(pa2, (bf16x8){l2[0], l2[1], l2[2], l2[3], h2[0], h2[1], h2[2], h2[3]}, o[d0], 0, 0, 0); \
        o[d0] = __builtin_amdgcn_mfma_f32_32x32x16_bf16(pa3, (bf16x8){l3[0], l3[1], l3[2], l3[3], h3[0], h3[1], h3[2], h3[3]}, o[d0], 0, 0, 0); } while (0)
    PV_D0(0); PV_D0(1); PV_D0(2); PV_D0(3);
#undef PV_D0
#undef TRRD
}
__device__ __forceinline__ void pack_p(const f32x16& p0, const f32x16& p1, bf16x8& pa0, bf16x8& pa1, bf16x8& pa2, bf16x8& pa3) {
#define PK4(P, B_, OUT) do { unsigned a0 = cvt_pk_bf16(P[B_+0], P[B_+1]), a1 = cvt_pk_bf16(P[B_+2], P[B_+3]); \
        unsigned b0 = cvt_pk_bf16(P[B_+4], P[B_+5]), b1 = cvt_pk_bf16(P[B_+6], P[B_+7]); \
        auto r0 = __builtin_amdgcn_permlane32_swap(a0, b0, false, false); auto r1 = __builtin_amdgcn_permlane32_swap(a1, b1, false, false); \
        u32x4 w = {r0[0], r1[0], r0[1], r1[1]}; OUT = __builtin_bit_cast(bf16x8, w); } while (0)
    PK4(p0, 0, pa0); PK4(p0, 8, pa1); PK4(p1, 0, pa2); PK4(p1, 8, pa3);
#undef PK4
}
template <bool NORM_L>
__device__ __forceinline__ void head_epilogue(f32x16* o, float l_own, LAS unsigned char* lds, int wid, int r32, int hi, const float* gain, bf16_t* Mrg, int grow0  , int gcol0  ) {
    LAS float* li_l = (LAS float*)(lds + OFF_WS) + wid * 64;
    if (NORM_L) {
        const float l = l_own + partner(l_own, hi);
        if (hi == 0) li_l[r32] = l;
        asm volatile("s_waitcnt lgkmcnt(0)" ::: "memory");
#pragma unroll
        for (int r = 0; r < 16; ++r) { const float rl = __builtin_amdgcn_rcpf(li_l[crow(r, hi)]);
#pragma unroll
            for (int d0 = 0; d0 < 4; ++d0) o[d0][r] *= rl; }
    }
    float gv[4];
#pragma unroll
    for (int d0 = 0; d0 < 4; ++d0) gv[d0] = gain[d0 * 32 + r32];
#pragma unroll
    for (int r = 0; r < 16; ++r) {
        float ss = (o[0][r] * o[0][r] + o[1][r] * o[1][r]) + (o[2][r] * o[2][r] + o[3][r] * o[3][r]);
        ss += __shfl_xor(ss, 1); ss += __shfl_xor(ss, 2); ss += __shfl_xor(ss, 4); ss += __shfl_xor(ss, 8); ss += __shfl_xor(ss, 16);
        const float rn = __builtin_amdgcn_rsqf(ss * (1.0f / HD) + EPS);
        const int orow = crow(r, hi);
#pragma unroll
        for (int d0 = 0; d0 < 4; ++d0) { const float v = o[d0][r] * rn * gv[d0]; const float vn = __shfl_xor(v, 1);
            if ((r32 & 1) == 0) *(unsigned*)(Mrg + pg8::img_off(grow0 + orow, gcol0 + d0 * 32 + r32, DM)) = cvt_pk_bf16(v, vn); }
    }
}

__device__ __forceinline__ void sb_part1(f32x16& p0, f32x16& p1, float& R, bool diag, int dq, int hi) {
    float sp0[16], sp1[16];
#pragma unroll
    for (int r = 0; r < 16; ++r) { const int c_ = (r & 3) + 8 * (r >> 2);
        float y0 = fminf(p0[r] * C2, 100.f), y1 = fminf(p1[r] * C2, 100.f);
        float s0 = __builtin_amdgcn_logf(1.0f + __builtin_amdgcn_exp2f(y0)), s1 = __builtin_amdgcn_logf(1.0f + __builtin_amdgcn_exp2f(y1));
        sp0[r] = s0; sp1[r] = s1; p0[r] = y0 - s0; p1[r] = y1 - s1; (void)c_; }
    if (diag) {
        asm volatile("; diagonal tile" ::: "memory");
#pragma unroll
        for (int r = 0; r < 16; ++r) { const int c_ = (r & 3) + 8 * (r >> 2);
            if (!(c_ < dq)) { sp0[r] = 0.f; p0[r] = -__builtin_inff(); } if (!(c_ + 32 < dq)) { sp1[r] = 0.f; p1[r] = -__builtin_inff(); } } }
    float G_[8], T_[8];
#pragma unroll
    for (int g = 0; g < 4; ++g) { G_[g] = (sp0[4 * g] + sp0[4 * g + 1]) + (sp0[4 * g + 2] + sp0[4 * g + 3]); G_[4 + g] = (sp1[4 * g] + sp1[4 * g + 1]) + (sp1[4 * g + 2] + sp1[4 * g + 3]); }
    T_[7] = 0.f;
#pragma unroll
    for (int g = 6; g >= 0; --g) T_[g] = T_[g + 1] + G_[g + 1];
    const float tot_ = T_[0] + G_[0];
#pragma unroll
    for (int g = 0; g < 8; ++g) { const float send_ = T_[g] + (hi ? G_[g] : 0.f); T_[g] = R + T_[g] + partner(send_, hi); }
    R += tot_ + partner(tot_, hi);
#pragma unroll
    for (int g = 0; g < 4; ++g) {
        float s3 = T_[g], s2 = s3 + sp0[4 * g + 3], s1_ = s2 + sp0[4 * g + 2], s0_ = s1_ + sp0[4 * g + 1];
        p0[4 * g + 3] -= s3; p0[4 * g + 2] -= s2; p0[4 * g + 1] -= s1_; p0[4 * g] -= s0_;
        s3 = T_[4 + g]; s2 = s3 + sp1[4 * g + 3]; s1_ = s2 + sp1[4 * g + 2]; s0_ = s1_ + sp1[4 * g + 1];
        p1[4 * g + 3] -= s3; p1[4 * g + 2] -= s2; p1[4 * g + 1] -= s1_; p1[4 * g] -= s0_; }
}
__device__ __forceinline__ void sb_finish(f32x16& p0, f32x16& p1, bf16x8& pa0, bf16x8& pa1, bf16x8& pa2, bf16x8& pa3) {
#pragma unroll
    for (int r = 0; r < 16; ++r) { p0[r] = __builtin_amdgcn_exp2f(p0[r]); p1[r] = __builtin_amdgcn_exp2f(p1[r]); }
    pack_p(p0, p1, pa0, pa1, pa2, pa3);
}
__device__ __forceinline__ void fox_part1(f32x16& p0, f32x16& p1, float& m_reg, float& alpha, bool diag, int dq, int hi) {
    if (diag) {
        asm volatile("; diagonal tile" ::: "memory");
#pragma unroll
        for (int r = 0; r < 16; ++r) { const int c_ = (r & 3) + 8 * (r >> 2); if (!(c_ <= dq)) p0[r] = -__builtin_inff(); if (!(c_ + 32 <= dq)) p1[r] = -__builtin_inff(); } }
    float pmax = p0[0];
#pragma unroll
    for (int r = 1; r < 16; ++r) pmax = fmaxf(pmax, p0[r]);
#pragma unroll
    for (int r = 0; r < 16; ++r) pmax = fmaxf(pmax, p1[r]);
    pmax = fmaxf(pmax, partner(pmax, hi));
    if (__all((pmax - m_reg) * SCALE <= 8.0f)) alpha = 1.f;
    else { const float mn = fmaxf(m_reg, pmax); alpha = __builtin_amdgcn_exp2f((m_reg - mn) * C2); m_reg = mn; }
    const float mnL = -m_reg * C2;
#pragma unroll
    for (int r = 0; r < 16; ++r) { p0[r] = fmaf(p0[r], C2, mnL); p1[r] = fmaf(p1[r], C2, mnL); }
#pragma unroll
    for (int r = 0; r < 16; ++r) p0[r] = __builtin_amdgcn_exp2f(p0[r]);
}
__device__ __forceinline__ void fox_finish(f32x16& p0, f32x16& p1, float alpha, float& l_reg, bf16x8& pa0, bf16x8& pa1, bf16x8& pa2, bf16x8& pa3) {
#pragma unroll
    for (int r = 0; r < 16; ++r) p1[r] = __builtin_amdgcn_exp2f(p1[r]);
    float ps = 0.f;
#pragma unroll
    for (int r = 0; r < 16; ++r) ps += p0[r] + p1[r];
    l_reg = l_reg * alpha + ps;
    pack_p(p0, p1, pa0, pa1, pa2, pa3);
}

template <int TYPE>
__device__ __forceinline__ void attn_block(const bf16_t* Qg, const bf16_t* Kg, const bf16_t* Vg, bf16_t* Mrg, int grow_b  , int gcol0  , const float* gain, const float* clr, int P0, LAS unsigned char* lds) {
    const int tid = threadIdx.x, wid = __builtin_amdgcn_readfirstlane(tid >> 6), lane = tid & 63, r32 = lane & 31, hi = lane >> 5;
    const int qlo = P0 + wid * 32, qpos = qlo + r32;
    bf16x8 qr[8];
#pragma unroll
    for (int d0 = 0; d0 < 8; ++d0) qr[d0] = *(const bf16x8*)(Qg + (size_t)qpos * PITCH + d0 * 16 + hi * 8);
    const int NT = P0 / KVBLK + 4;
    const int sr = tid >> 4, sc = (tid & 15) * 8, vst0 = v_st(sr, sc), vst1 = v_st(32 + sr, sc), kws = KSWZ(sr, sc * 2);
    const int vbase = (int)(unsigned)(uintptr_t)lds + v_rd_base(lane);
    LAS volatile int* vote = (LAS volatile int*)(lds + OFF_VOTE);
    LAS const float* CB = (LAS const float*)(lds + OFF_CB);
    LAS const float* KP = (LAS const float*)(lds + OFF_KP);
    LAS float* CLB = (LAS float*)(lds + OFF_CLB);
    LAS float* al_l = (LAS float*)(lds + OFF_WS) + wid * 64 + 32;
    f32x16 o[4];
#pragma unroll
    for (int d0 = 0; d0 < 4; ++d0)
#pragma unroll
        for (int r = 0; r < 16; ++r) o[d0][r] = 0.f;
    float R = 0.f, m_reg = -1e30f, l_reg = 0.f, ctr = 0.f, qn = 0.f;
    float clv = 0.f; if (TYPE == 1) clv = clr[qpos];
    constexpr int NOPS = (TYPE == 1) ? 5 : 4;
    unsigned koff[2], voff[2];
#pragma unroll
    for (int j = 0; j < 2; ++j) { const int W = wid * 2 + j, row = 4 * W + (lane >> 4), c = (lane & 15) ^ (row & 7); koff[j] = (unsigned)(row * PITCH + c * 8);
        const int sv = 2 * W + (lane >> 5), kk = (sv >> 2) * 8 + ((lane & 31) >> 2), k = (kk & ~0xC) | ((kk & 4) << 1) | ((kk & 8) >> 1); voff[j] = (unsigned)(k * PITCH + (sv & 3) * 32 + (lane & 3) * 8); }
#define DMA_TILE(t_, ks_, vs_) do { const bf16_t* kt_ = Kg + (size_t)(t_) * KVBLK * PITCH; const bf16_t* vt_ = Vg + (size_t)(t_) * KVBLK * PITCH; \
        _Pragma("unroll") for (int j = 0; j < 2; ++j) __builtin_amdgcn_global_load_lds((const unsigned*)(kt_ + koff[j]), (LAS unsigned*)(lds + OFF_K + (ks_) * SHM + (wid * 2 + j) * 1024), 16, 0, 0); \
        _Pragma("unroll") for (int j = 0; j < 2; ++j) __builtin_amdgcn_global_load_lds((const unsigned*)(vt_ + voff[j]), (LAS unsigned*)(lds + (vs_) * SHM + (wid * 2 + j) * 1024), 16, 0, 0); \
        if (TYPE == 1) __builtin_amdgcn_global_load_lds((const unsigned*)(clr + (t_) * KVBLK + lane), (LAS unsigned*)(lds + OFF_CLB + (ks_) * 256), 4, 0, 0); } while (0)
#define WAIT_TILES(n_) asm volatile("s_waitcnt vmcnt(%0)" :: "n"(n_) : "memory")
#define STEP_BAR() do { asm volatile("s_waitcnt lgkmcnt(0)" ::: "memory"); __builtin_amdgcn_s_barrier(); asm volatile("" ::: "memory"); } while (0)
    DMA_TILE(NT - 1, 0, 0); DMA_TILE(NT - 2, 1, 1);
    if (TYPE == 1) {
        ctr = CB[qpos >> 6] + clv;
        float s = 0.f;
#pragma unroll
        for (int d0 = 0; d0 < 8; ++d0) { const u32x4 w = __builtin_bit_cast(u32x4, qr[d0]);
#pragma unroll
            for (int j = 0; j < 4; ++j) { const float a = __uint_as_float(w[j] << 16), b = __uint_as_float(w[j] & 0xffff0000u); s = fmaf(a, a, s); s = fmaf(b, b, s); } }
        s += partner(s, hi); qn = sqrtf(s) * 1.01f;
    }
    WAIT_TILES(NOPS); STEP_BAR();
    f32x16 P0r, P1r; bf16x8 pa0, pa1, pa2, pa3;
    int k3 = 0, ilast = 0;
    for (int i = 0;; ++i) {
        const int t_ = NT - 1 - i, kb_ = t_ * KVBLK; const bool more_ = (i + 1 < NT), more2 = (i + 2 < NT);
        const bool actX = (kb_ <= qlo), actY = (i >= 1) && (kb_ + KVBLK <= qlo);
        float dr_ = 0.f;
        if (more2) DMA_TILE(t_ - 2, (k3 == 0 ? 2 : k3 - 1), (i + 2) & 3);
        if (actX) {
            if (TYPE == 1) { dr_ = ctr - CB[t_];
#pragma unroll
                for (int g = 0; g < 4; ++g) { const f32x4 c0 = *(LAS const f32x4*)(CLB + k3 * 64 + 8 * g + 4 * hi), c1 = *(LAS const f32x4*)(CLB + k3 * 64 + 32 + 8 * g + 4 * hi);
#pragma unroll
                    for (int j = 0; j < 4; ++j) { P0r[4 * g + j] = dr_ - c0[j]; P1r[4 * g + j] = dr_ - c1[j]; } } }
            else {
#pragma unroll
                for (int r = 0; r < 16; ++r) { P0r[r] = 0.f; P1r[r] = 0.f; } }
            SBAR(); qkt(P0r, P1r, lds + OFF_K + k3 * SHM, r32, hi, qr); }
        SBAR();
        if (actY) pv_tile(o, vbase + ((i - 1) & 3) * SHM, pa0, pa1, pa2, pa3);
        SBAR();
        bool done_ = false;
        if (actX) {
            if (TYPE == 1) { float alpha_; fox_part1(P0r, P1r, m_reg, alpha_, kb_ + KVBLK - 1 > qlo, qpos - kb_ - 4 * hi, hi);
                if (__any(alpha_ < 1.f)) { if (hi == 0) al_l[r32] = alpha_; asm volatile("s_waitcnt lgkmcnt(0)" ::: "memory");
#pragma unroll
                    for (int r = 0; r < 16; ++r) { const float a_ = al_l[crow(r, hi)];
#pragma unroll
                        for (int d_ = 0; d_ < 4; ++d_) o[d_][r] *= a_; } }
                fox_finish(P0r, P1r, alpha_, l_reg, pa0, pa1, pa2, pa3);
                done_ = (t_ >= 1) && __all(qn * KP[t_ >= 1 ? t_ - 1 : 0] + dr_ - m_reg < -1000.f); }
            else { sb_part1(P0r, P1r, R, kb_ + KVBLK - 1 >= qlo, qpos - kb_ - 4 * hi, hi); sb_finish(P0r, P1r, pa0, pa1, pa2, pa3); done_ = SB_EARLY_EXIT && __all(R > 128.0f); } }
        if (lane == 0) vote[(i & 1) * 8 + wid] = done_ ? 1 : 0;
        if (more2) WAIT_TILES(NOPS); else WAIT_TILES(0);
        STEP_BAR();
        int v_ = 1;
#pragma unroll
        for (int w_ = 0; w_ < 8; ++w_) v_ &= vote[(i & 1) * 8 + w_];
        if (v_ != 0 || !more_) { ilast = i; break; }
        k3 = (k3 == 2) ? 0 : k3 + 1;
    }
    if ((NT - 1 - ilast) * KVBLK <= qlo) pv_tile(o, vbase + (ilast & 3) * SHM, pa0, pa1, pa2, pa3);
    WAIT_TILES(0);
#undef DMA_TILE
#undef WAIT_TILES
#undef STEP_BAR
    head_epilogue<TYPE == 1>(o, l_reg, lds, wid, r32, hi, gain, Mrg, grow_b + qlo, gcol0);
    __syncthreads();
}
}

constexpr size_t MiB = 1u << 20;
constexpr size_t WS_CTL = 0, CTL_ZERO_BYTES = 2 * MiB;
constexpr size_t WS_WGU1 = 2 * MiB;
constexpr size_t WS_WD1 = WS_WGU1 + 172 * MiB;
constexpr size_t WS_WIN = WS_WD1 + 86 * MiB;
constexpr size_t WS_WF = WS_WIN + 96 * MiB;
constexpr size_t WS_WO = WS_WF + 1 * MiB;
constexpr size_t WS_WGU2 = WS_WO + 32 * MiB;
constexpr size_t WS_WD2 = WS_WGU2 + 172 * MiB;
constexpr size_t WS_AB = WS_WD2 + 86 * MiB;
constexpr size_t WS_MRG = WS_AB + 128 * MiB;
constexpr size_t WS_BIG = WS_MRG + 128 * MiB;
constexpr size_t WS_CL = WS_BIG + 384 * MiB;
constexpr size_t WS_CT = WS_CL + 1 * MiB;
constexpr size_t WS_END = WS_CT + 1 * MiB;
static_assert((size_t)2 * DFF * DM * 2 <= 172 * MiB && (size_t)DM * DFF * 2 <= 86 * MiB && (size_t)NQKV * DM * 2 <= 96 * MiB && (size_t)M * DFF * 2 <= 384 * MiB && (size_t)6 * M * GW * 2 <= 384 * MiB, "ws map");
constexpr int CW_BAR = 4096;
constexpr int CW_PNL = 12288;
constexpr int CW_GQ = 32768;
constexpr int CW_CONV = 16384 + 4096;
constexpr int CW_Q = 8192;
constexpr size_t CTL_RSS = 1 * MiB;

constexpr int RING_BYTES = 131072, LDSCTL_OFF = RING_BYTES, MISC_OFF = LDSCTL_OFF + 320, LDS_BYTES = 147456;
static_assert(att::ATT_LDS_BYTES <= RING_BYTES, "attention scratch inside the ring");

#define XB_TMO      128
#define XB_XCNT(j)  (256  + 64 * (j))
#define XB_XSUB(j)  (1280 + 64 * (j))
#define XB_XGEN(j)  (2304 + 64 * (j))
#define XB_TOP      3328
#define XB_TOPGEN   3392
#define XCD_BAR_WORDS 3456
#define XB_SPIN_CAP (1u << 18)
__device__ __forceinline__ unsigned xb_ld(unsigned* p)              { return __hip_atomic_load(p, __ATOMIC_RELAXED, __HIP_MEMORY_SCOPE_AGENT); }
__device__ __forceinline__ unsigned xb_add(unsigned* p, unsigned v) { return __hip_atomic_fetch_add(p, v, __ATOMIC_RELAXED, __HIP_MEMORY_SCOPE_AGENT); }
__device__ __forceinline__ unsigned xb_xcc_id() { return (unsigned)__builtin_amdgcn_s_getreg((3 << 11) | 20) & 0xFu; }
#define XB_SPIN(cond, bar) do { unsigned _sp = 0; while (cond) { __builtin_amdgcn_s_sleep(1); \
    if ((++_sp & 255u) == 0u) { if (xb_ld(&(bar)[XB_TMO])) break; if (_sp > XB_SPIN_CAP) { atomicAdd(&(bar)[XB_TMO], 1u); break; } } } } while (0)
struct XcdBarrier { unsigned* bar; unsigned x; volatile LAS unsigned* st; };
__device__ __forceinline__ XcdBarrier xcd_barrier_post(unsigned* bar, volatile LAS unsigned* st) {
    XcdBarrier b; b.bar = bar; b.x = xb_xcc_id(); b.st = st;
    if (threadIdx.x == 0) (void)xb_add(&bar[XB_XCNT(b.x)], 1u);
    return b;
}
__device__ __forceinline__ void xcd_barrier_complete(unsigned* bar, unsigned x, unsigned& nloc, unsigned& nx) {
    const unsigned G = gridDim.x * gridDim.y * gridDim.z;
    unsigned sum, cnt, mine, sp = 0u;
    for (;;) {
        sum = 0u; cnt = 0u; mine = 0u;
#pragma unroll
        for (unsigned j = 0; j < 16; ++j) { const unsigned c = xb_ld(&bar[XB_XCNT(j)]); sum += c; cnt += (c > 0u) ? 1u : 0u; mine = (j == x) ? c : mine; }
        if (sum == G) break;
        __builtin_amdgcn_s_sleep(1);
        if ((++sp & 255u) == 0u) { if (xb_ld(&bar[XB_TMO])) break; if (sp > XB_SPIN_CAP) { atomicAdd(&bar[XB_TMO], 1u); break; } }
    }
    nloc = mine > 0u ? mine : 1u; nx = cnt > 0u ? cnt : 1u;
}
__device__ __forceinline__ void xcd_barrier(const XcdBarrier& b) {
    asm volatile("s_waitcnt vmcnt(0)" ::: "memory");
    __syncthreads();
    if (threadIdx.x == 0) {
        unsigned* bar = b.bar;
        __builtin_amdgcn_s_waitcnt(0);
        unsigned nloc = b.st[0], nx = b.st[1];
        if (nloc == 0u) { xcd_barrier_complete(bar, b.x, nloc, nx); b.st[0] = nloc; b.st[1] = nx; }
        const unsigned old = xb_add(&bar[XB_XSUB(b.x)], 1u);
        const unsigned gen = old / nloc;
        if (old + 1u == (gen + 1u) * nloc) {
            __builtin_amdgcn_fence(__ATOMIC_RELEASE, "agent");
            asm volatile("s_waitcnt vmcnt(0)" ::: "memory");
            const unsigned og = xb_add(&bar[XB_TOP], 1u);
            const unsigned tg = og / nx;
            if (og + 1u == (tg + 1u) * nx) xb_add(&bar[XB_TOPGEN], 1u);
            else XB_SPIN(xb_ld(&bar[XB_TOPGEN]) == tg, bar);
            __builtin_amdgcn_fence(__ATOMIC_ACQUIRE, "agent");
            xb_add(&bar[XB_XGEN(b.x)], 1u);
            asm volatile("s_waitcnt vmcnt(0)" ::: "memory");
        } else {
            XB_SPIN(xb_ld(&bar[XB_XGEN(b.x)]) == gen, bar);
            __builtin_amdgcn_fence(__ATOMIC_ACQUIRE, "agent");
            asm volatile("s_waitcnt vmcnt(0)" ::: "memory");
        }
    }
    __syncthreads();
}

__device__ __forceinline__ unsigned f2bf(float f) { unsigned u = __builtin_bit_cast(unsigned, f); return (u + 0x7fffu + ((u >> 16) & 1u)) >> 16; }
__device__ __forceinline__ unsigned pk2(float lo, float hi) { return f2bf(lo) | (f2bf(hi) << 16); }
__device__ __forceinline__ float wave_sum(float v) {
#pragma unroll
    for (int o = 1; o < 64; o <<= 1) v += __shfl_xor(v, o);
    return v;
}
__device__ __forceinline__ void tr_item(const float* W, int ldw, int K, int k0, int n0, int nvalid, const float* gain, bf16_t* WT, int orow0, LAS float* scr, int lane, bool image = true) {
    const int nl = lane & 31; const bool ok = nl < nvalid;
    float v[32];
#pragma unroll
    for (int i = 0; i < 32; ++i) { const int kk = 2 * i + (lane >> 5); v[i] = ok ? __builtin_nontemporal_load(W + (size_t)(k0 + kk) * ldw + n0 + nl) : 0.f; }
    if (gain) {
#pragma unroll
        for (int i = 0; i < 32; ++i) { const int kk = 2 * i + (lane >> 5); v[i] *= gain[k0 + kk]; } }
#pragma unroll
    for (int i = 0; i < 32; ++i) { const int kk = 2 * i + (lane >> 5); scr[kk * 33 + nl] = v[i]; }
    asm volatile("s_waitcnt lgkmcnt(0)" ::: "memory");
    const int c = lane & 7;
#pragma unroll
    for (int j = 0; j < 4; ++j) { const int n = (lane >> 3) + 8 * j; const LAS float* s = scr + (8 * c) * 33 + n;
        u32x4 o; o.x = pk2(s[0 * 33], s[1 * 33]); o.y = pk2(s[2 * 33], s[3 * 33]); o.z = pk2(s[4 * 33], s[5 * 33]); o.w = pk2(s[6 * 33], s[7 * 33]);
        if (n < nvalid) *(u32x4*)(WT + (image ? pg8::img_off_b(orow0 + n, k0 + 8 * c, K) : (size_t)(orow0 + n) * K + k0 + 8 * c)) = o; }
    asm volatile("s_waitcnt lgkmcnt(0)" ::: "memory");
}

struct Args { const float* in[16]; float* out; unsigned char* ws; int ph_lo, ph_hi, flag, pad; };
constexpr int NPH = 9;

__global__ void __launch_bounds__(512, 2) mk_fwd(Args args) {
    extern __shared__ __attribute__((aligned(16))) unsigned char lds_raw[];
    LAS unsigned char* lds = (LAS unsigned char*)lds_raw;
    volatile LAS unsigned* MISC = (volatile LAS unsigned*)(lds + MISC_OFF);
    const int tid = threadIdx.x, lane = tid & 63, wave = __builtin_amdgcn_readfirstlane(tid >> 6);
    const int G = gridDim.x, bx = blockIdx.x;
    const int vcu = (G % 8 == 0) ? (bx % 8) * (G / 8) + bx / 8 : bx;
    unsigned char* ws = args.ws;
    unsigned* ctl = (unsigned*)(ws + WS_CTL);
    const float* x = args.in[0]; const float* g_ffn1 = args.in[1]; const float* w_gate1 = args.in[2]; const float* w_up1 = args.in[3]; const float* w_down1 = args.in[4];
    const float* g_mix = args.in[5]; const float* w_in = args.in[6]; const float* b_f = args.in[7]; const float* g_sb = args.in[8]; const float* g_fox = args.in[9];
    const float* w_o = args.in[10]; const float* g_ffn2 = args.in[11]; const float* w_gate2 = args.in[12]; const float* w_up2 = args.in[13]; const float* w_down2 = args.in[14];
    const float* g_fin = args.in[15];
    float* out = args.out;
    bf16_t* Wgu1 = (bf16_t*)(ws + WS_WGU1); bf16_t* Wd1 = (bf16_t*)(ws + WS_WD1); bf16_t* Win = (bf16_t*)(ws + WS_WIN); bf16_t* Wf = (bf16_t*)(ws + WS_WF);
    bf16_t* Wo = (bf16_t*)(ws + WS_WO); bf16_t* Wgu2 = (bf16_t*)(ws + WS_WGU2); bf16_t* Wd2 = (bf16_t*)(ws + WS_WD2);
    bf16_t* AB = (bf16_t*)(ws + WS_AB); bf16_t* MRG = (bf16_t*)(ws + WS_MRG); bf16_t* BIG = (bf16_t*)(ws + WS_BIG);
    float* CL = (float*)(ws + WS_CL); float* CT = (float*)(ws + WS_CT);
    float* rss0 = (float*)(ws + CTL_RSS); float* rss1 = rss0 + M; float* rss2 = rss1 + M; float* rss3 = rss2 + M; float* tmx = rss3 + M;

    for (int u = tid; u < (LDS_BYTES - LDSCTL_OFF) / 4; u += 512) ((LAS unsigned*)(lds + LDSCTL_OFF))[u] = 0u;
    __syncthreads();
    XcdBarrier bar; bar.bar = ctl + CW_BAR; bar.x = 0; bar.st = nullptr;
    if (MK_N_LAUNCHES == 1) bar = xcd_barrier_post(ctl + CW_BAR, MISC + 8);
    const int lo = args.ph_lo, hi_ph = args.ph_hi;
#define IN(k) (lo <= (k) && (k) < hi_ph)
#define SEAM(k) do { if (IN(k) && IN((k) + 1)) xcd_barrier(bar); } while (0)

    constexpr int CV_KB_D = DM / 64, CV_KB_F = DFF / 64, CV_NB_F = DFF / 32, CV_NB_D = DM / 32, CV_NB_Q = NQKV / 32;
    constexpr int CV_I_G = CV_KB_D * CV_NB_F, CV_I_DN = CV_KB_F * CV_NB_D, CV_I_IN = CV_KB_D * (CV_NB_Q + 1), CV_I_O = CV_KB_D * CV_NB_D;
    constexpr int CV_GU2 = 2 * CV_I_G, CV_DN1 = 4 * CV_I_G, CV_DN2 = CV_DN1 + CV_I_DN, CV_IN = CV_DN2 + CV_I_DN, CV_O = CV_IN + CV_I_IN;
    constexpr int CV_BATCH = 4;
#define CONV_TAIL(k_, lo_, n_) do { \
        constexpr int KB_D = CV_KB_D, KB_F = CV_KB_F, NB_F = CV_NB_F, NB_D = CV_NB_D, NB_Q = CV_NB_Q, I_G = CV_I_G, I_DN = CV_I_DN, I_IN = CV_I_IN; \
        (void)KB_D; (void)KB_F; \
        LAS float* scr = (LAS float*)(lds + wave * 16384); \
        volatile LAS int* cslot_ = (volatile LAS int*)(lds + LDS_BYTES - 32); \
        for (;;) { if (tid == 0) *cslot_ = (int)xb_add(ctl + CW_CONV + 64 * (k_), (unsigned)(8 * CV_BATCH)); \
            __syncthreads(); const int base_ = __builtin_amdgcn_readfirstlane(*cslot_); __syncthreads(); \
            if (base_ >= (n_)) break; \
            for (int i_ = 0; i_ < CV_BATCH; ++i_) { const int it_ = base_ + i_ * 8 + wave; if (it_ < (n_)) CONV_ITEM((lo_) + it_); } } \
    } while (0)

    if (IN(0)) {
        LAS float* scr = (LAS float*)(lds + wave * 16384);
        const int gw = vcu * 8 + wave, NGW = G * 8;
        constexpr int KB_D = DM / 64, KB_F = DFF / 64;
        constexpr int NB_F = DFF / 32, NB_D = DM / 32, NB_Q = NQKV / 32;
        constexpr int I_G = KB_D * NB_F, I_DN = KB_F * NB_D, I_IN = KB_D * (NB_Q + 1), I_O = KB_D * NB_D;
        constexpr int NITEMS = 4 * I_G + 2 * I_DN + I_IN + I_O;
#define CONV_ITEM(it_) do { const int it = (it_); \
            int r = it; \
            if (r < 4 * I_G) { \
                const int which = r / I_G; r -= which * I_G; const int kb = r / NB_F, nb = r % NB_F, n0 = nb * 32; \
                const float* W = which == 0 ? w_gate1 : which == 1 ? w_up1 : which == 2 ? w_gate2 : w_up2; \
                bf16_t* WT = which < 2 ? Wgu1 : Wgu2; const float* gn = which < 2 ? g_ffn1 : g_ffn2; \
                const int orow0 = (n0 >> 7) * 256 + (which & 1) * 128 + (n0 & 127); \
                tr_item(W, DFF, DM, kb * 64, n0, 32, gn, WT, orow0, scr, lane); break; } \
            r -= 4 * I_G; \
            if (r < 2 * I_DN) { \
                const int which = r / I_DN; r -= which * I_DN; const int kb = r / NB_D, nb = r % NB_D; \
                tr_item(which ? w_down2 : w_down1, DM, DFF, kb * 64, nb * 32, 32, nullptr, which ? Wd2 : Wd1, nb * 32, scr, lane); break; } \
            r -= 2 * I_DN; \
            if (r < I_IN) { \
                const int kb = r / (NB_Q + 1), nb = r % (NB_Q + 1); \
                if (nb < NB_Q) tr_item(w_in, IN_PROJ, DM, kb * 64, nb * 32, 32, g_mix, Win, nb * 32, scr, lane); \
                else tr_item(w_in, IN_PROJ, DM, kb * 64, NQKV, 16, g_mix, Wf, 0, scr, lane, false); \
                break; } \
            r -= I_IN; \
            { const int kb = r / NB_D, nb = r % NB_D; tr_item(w_o, DM, DM, kb * 64, nb * 32, 32, nullptr, Wo, nb * 32, scr, lane); } \
        } while (0)
        (void)NITEMS;
        for (int j = gw; j < 2 * I_G; j += NGW) CONV_ITEM(j);
        for (int m = gw; m < M; m += NGW) {
            const f32x4* xr = (const f32x4*)(x + (size_t)m * DM) + lane; float ss = 0.f; f32x4 v[16];
#pragma unroll
            for (int j = 0; j < 16; ++j) { v[j] = __builtin_nontemporal_load(xr + 64 * j); ss += (v[j][0] * v[j][0] + v[j][1] * v[j][1]) + (v[j][2] * v[j][2] + v[j][3] * v[j][3]); }
            ss = wave_sum(ss);
            if (lane == 0) rss0[m] = ss;
#pragma unroll
            for (int j = 0; j < 16; ++j) { u32x2 w; w.x = cvt_pk_bf16(v[j][0], v[j][1]); w.y = cvt_pk_bf16(v[j][2], v[j][3]); *(u32x2*)(AB + pg8::img_off(m, 4 * (lane + 64 * j), DM)) = w; }
        }
    }
    SEAM(0);

    if (IN(1)) {
        pg8::Gemm g{AB, Wgu1, M, 2 * DFF, DM}; pg8::DynOrder S{ctl + CW_GQ, 8 * (2 * DFF / pg8::BM), (int)(xb_xcc_id() & 7u), (volatile LAS int*)(lds + LDS_BYTES - 64)};
        pg8::EpiSwiglu E{BIG, rss0};
        pg8::gemm_phase<pg8::EpiSwiglu, pg8::DynOrder, true, true>(lds, g, S, E);
        CONV_TAIL(0, CV_DN1, CV_I_DN);
    }
    SEAM(1);
    if (IN(2)) {
        pg8::Gemm g{BIG, Wd1, M, DM, DFF}; pg8::StaticOrder S; S.init(M, DM, G, bx, 2);
        pg8::EpiResid<true, false> E{AB, AB, rss1, 0.5f};
        pg8::gemm_phase<pg8::EpiResid<true, false>, pg8::StaticOrder, true, true>(lds, g, S, E);
        CONV_TAIL(1, CV_IN, CV_I_IN);
    }
    SEAM(2);
    if (IN(3)) {
        {
        pg8::Gemm g{AB, Win, M, NQKV, DM}; pg8::DynOrder S{ctl + CW_GQ + 512, 8 * (NQKV / pg8::BM), (int)(xb_xcc_id() & 7u), (volatile LAS int*)(lds + LDS_BYTES - 64)};
        pg8::EpiQKV E{BIG, rss1, tmx};
        pg8::gemm_phase<pg8::EpiQKV, pg8::DynOrder, true, true>(lds, g, S, E);
        }
        LAS float* lf = (LAS float*)lds;
        for (int ch = vcu; ch < M / 64; ch += G) {
            if (wave < 4) {
                const int fr = lane & 15, fq = lane >> 4; const int rowA = ch * 64 + wave * 16 + fr;
                const bf16_t* bp = Wf + (size_t)fr * DM + fq * 8;
                f32x4 acc = {0.f, 0.f, 0.f, 0.f};
#pragma unroll 8
                for (int k0 = 0; k0 < DM; k0 += 32) acc = __builtin_amdgcn_mfma_f32_16x16x32_bf16(*(const bf16x8*)(AB + pg8::img_off(rowA, k0 + fq * 8, DM)), *(const bf16x8*)(bp + k0), acc, 0, 0, 0);
                const float bias = b_f[fr];
#pragma unroll
                for (int j = 0; j < 4; ++j) { const int rl = wave * 16 + fq * 4 + j; const float r = rstd_of(ld_agent_f32(rss1 + ch * 64 + rl));
                    const float v = acc[j] * r + bias; const float ls = fminf(v, 0.f) - log1pf(expf(-fabsf(v))); lf[rl * 16 + fr] = ls; }
            }
            __syncthreads();
            if (tid < 16) { const int b = (ch * 64) / SEQ, s0 = (ch * 64) % SEQ; float run = 0.f; float* clp = CL + ((size_t)(b * NH + tid)) * SEQ + s0;
                for (int r = 0; r < 64; ++r) { run += lf[r * 16 + tid]; clp[r] = run * (1.0f / att::SCALE); }
                CT[(b * NH + tid) * 128 + (s0 >> 6)] = run * (1.0f / att::SCALE); }
            __syncthreads();
        }
        CONV_TAIL(5, CV_GU2, CV_I_G);
    }
    SEAM(3);
    if (IN(4)) {
        const size_t TS = (size_t)M * GW;
        const int myq = (int)(xb_xcc_id() & 7u);
        volatile LAS int* slot = (volatile LAS int*)(lds + att::OFF_SLOT);
        unsigned* qf = ctl + CW_Q + args.flag * 1024; unsigned* qs = qf + 8 * 64;
        int last_bh = -1;
        for (;;) {
            if (tid == 0) { int res = -1; for (int k = 0; k < 8; ++k) { const int q = (myq + k) & 7; const unsigned idx = xb_add(qf + 64 * q, 1u); if (idx < 128u) { res = q * 128 + (int)idx; break; } } *slot = res; }
            __syncthreads(); const int it = *slot; __syncthreads();
            if (it < 0) break;
            const int q = it >> 7, j = it & 127, bh = (j >> 5) * 8 + q, qb = 31 - (j & 31), b = bh >> 4, h = bh & 15;
            const size_t base = (size_t)b * SEQ * GW + (size_t)h * HD;
            if (bh != last_bh) {
                if (wave == 0) {
                    const float* ct = CT + bh * 128; const float v0 = ct[2 * lane], v1 = ct[2 * lane + 1]; const float s = v0 + v1; float inc = s;
#pragma unroll
                    for (int o = 1; o < 64; o <<= 1) { const float tq = __shfl_up(inc, o); if (lane >= o) inc += tq; }
                    const float ex = inc - s; LAS float* CBw = (LAS float*)(lds + att::OFF_CB); CBw[2 * lane] = ex; CBw[2 * lane + 1] = ex + v0; }
                if (wave == 1) {
                    const float v0 = sqrtf(ld_agent_f32(tmx + bh * 128 + 2 * lane)) * 1.01f, v1 = sqrtf(ld_agent_f32(tmx + bh * 128 + 2 * lane + 1)) * 1.01f; float inc = fmaxf(v0, v1);
#pragma unroll
                    for (int o = 1; o < 64; o <<= 1) { const float tq = __shfl_up(inc, o); if (lane >= o) inc = fmaxf(inc, tq); }
                    float ex = __shfl_up(inc, 1); if (lane == 0) ex = 0.f;
                    LAS float* KPw = (LAS float*)(lds + att::OFF_KP); KPw[2 * lane] = fmaxf(ex, v0); KPw[2 * lane + 1] = inc; }
                __syncthreads(); last_bh = bh;
            }
            att::attn_block<1>(BIG + 3 * TS + base, BIG + 4 * TS + base, BIG + 5 * TS + base, MRG, b * SEQ, GW + h * HD, g_fox + h * HD,
                               CL + (size_t)bh * SEQ, qb * att::QB, lds);
        }
        for (;;) {
            if (tid == 0) { int res = -1; for (int k = 0; k < 8; ++k) { const int q = (myq + k) & 7; const unsigned idx = xb_add(qs + 64 * q, 1u); if (idx < 128u) { res = q * 128 + (int)idx; break; } } *slot = res; }
            __syncthreads(); const int it = *slot; __syncthreads();
            if (it < 0) break;
            const int q = it >> 7, j = it & 127, bh = (j >> 5) * 8 + q, qb = 31 - (j & 31), b = bh >> 4, h = bh & 15;
            const size_t base = (size_t)b * SEQ * GW + (size_t)h * HD;
            att::attn_block<0>(BIG + base, BIG + TS + base, BIG + 2 * TS + base, MRG, b * SEQ, h * HD, g_sb + h * HD, nullptr, qb * att::QB, lds);
        }
        CONV_TAIL(2, CV_O, CV_I_O);
    }
    SEAM(4);
    if (IN(5)) {
        pg8::Gemm g{MRG, Wo, M, DM, DM}; pg8::StaticOrder S; S.init(M, DM, G, bx, 2);
        pg8::EpiResid<true, false> E{AB, AB, rss2, 1.0f};
        pg8::gemm_phase<pg8::EpiResid<true, false>, pg8::StaticOrder, true, true>(lds, g, S, E);
        CONV_TAIL(3, CV_GU2 + CV_I_G, CV_I_G);
    }
    SEAM(5);
    if (IN(6)) {
        pg8::Gemm g{AB, Wgu2, M, 2 * DFF, DM}; pg8::DynOrder S{ctl + CW_GQ + 1024, 8 * (2 * DFF / pg8::BM), (int)(xb_xcc_id() & 7u), (volatile LAS int*)(lds + LDS_BYTES - 64)};
        pg8::EpiSwiglu E{BIG, rss2};
        pg8::gemm_phase<pg8::EpiSwiglu, pg8::DynOrder, true, true>(lds, g, S, E);
        CONV_TAIL(4, CV_DN2, CV_I_DN);
    }
    SEAM(6);
    if (IN(7)) {
        pg8::Gemm g{BIG, Wd2, M, DM, DFF}; pg8::StaticOrder S; S.init(M, DM, G, bx, 2);
        if (G == 256) {
            pg8::EpiResidNorm E{AB, out, rss3, ctl + CW_PNL, g_fin, 0.5f};
            pg8::gemm_phase<pg8::EpiResidNorm, pg8::StaticOrder, true, true>(lds, g, S, E);
        } else {
            pg8::EpiResid<true, true> E{AB, out, rss3, 0.5f};
            pg8::gemm_phase<pg8::EpiResid<true, true>, pg8::StaticOrder, true, true>(lds, g, S, E);
        }
    }
    if (G != 256) SEAM(7);
    if (IN(8) && G != 256) {
        const int gw = vcu * 8 + wave, NGW = G * 8;
        for (int m = gw; m < M; m += NGW) {
            const float r = rstd_of(ld_agent_f32(rss3 + m)); f32x4* xr = (f32x4*)(out + (size_t)m * DM) + lane; const f32x4* gr = (const f32x4*)g_fin + lane;
#pragma unroll
            for (int j = 0; j < 16; ++j) { const f32x4 v = xr[64 * j] * r * gr[64 * j]; xr[64 * j] = v; }
        }
    }
#undef IN
#undef SEAM
#undef CONV_ITEM
#undef CONV_TAIL
}

extern "C" void kernel_launch(void* const* d_in, const int* in_sizes, int n_in, void* d_out, int out_size, void* d_ws, size_t ws_size, hipStream_t stream) {
    static int grid = 0;
    if (grid == 0) {
        if (n_in != 16 || in_sizes[0] != M * DM || out_size != M * DM || ws_size < WS_END + MiB) {
            fprintf(stderr, "kernel_launch: shape/workspace mismatch (n_in %d in0 %d out %d ws %zu need %zu); nothing launched\n", n_in, n_in > 0 ? in_sizes[0] : -1, out_size, ws_size, (size_t)WS_END); grid = -1; return; }
        int dev = 0, cus = 0, per_cu = 0;
        if (hipGetDevice(&dev) != hipSuccess || hipDeviceGetAttribute(&cus, hipDeviceAttributeMultiprocessorCount, dev) != hipSuccess) { fprintf(stderr, "kernel_launch: device query failed\n"); grid = -1; return; }
        if (hipFuncSetAttribute((const void*)mk_fwd, hipFuncAttributeMaxDynamicSharedMemorySize, LDS_BYTES) != hipSuccess) { fprintf(stderr, "kernel_launch: hipFuncSetAttribute failed\n"); grid = -1; return; }
        if (hipOccupancyMaxActiveBlocksPerMultiprocessor(&per_cu, (const void*)mk_fwd, 512, LDS_BYTES) != hipSuccess || per_cu < 1)
            fprintf(stderr, "kernel_launch: note: occupancy query reports %d workgroups per CU\n", per_cu);
        (void)hipGetLastError();
        grid = cus;
    }
    if (grid < 0) return;
    (void)hipMemsetAsync((char*)d_ws + WS_CTL, 0, CTL_ZERO_BYTES, stream);
    Args a{};
    for (int i = 0; i < 16; ++i) a.in[i] = (const float*)d_in[i];
    a.out = (float*)d_out; a.ws = (unsigned char*)d_ws;
    if (MK_N_LAUNCHES == 1) { a.ph_lo = 0; a.ph_hi = NPH; hipLaunchKernelGGL(mk_fwd, dim3(grid), dim3(512), LDS_BYTES, stream, a); }
    else for (int p = 0; p < NPH; ++p) { a.ph_lo = p; a.ph_hi = p + 1; for (int rep = 0; rep < (p == PROBE_REP ? 2 : 1); ++rep) { a.flag = rep; hipLaunchKernelGGL(mk_fwd, dim3(grid), dim3(512), LDS_BYTES, stream, a); } }
    const hipError_t le = hipPeekAtLastError();
    if (le != hipSuccess) fprintf(stderr, "kernel_launch: launch failed: %s\n", hipGetErrorName(le));
}
```

```cpp
#include <hip/hip_runtime.h>
#include <cstdio>
#include <cstdint>

#ifndef MK_N_LAUNCHES
#define MK_N_LAUNCHES 1
#endif
#ifndef PROBE_REP
#define PROBE_REP -1
#endif
#ifndef SB_EARLY_EXIT
#define SB_EARLY_EXIT 1
#endif

#define LAS __attribute__((address_space(3)))
#define GAS __attribute__((address_space(1)))
typedef unsigned short bf16_t;
typedef short bf16x8 __attribute__((ext_vector_type(8)));
typedef short s16x4 __attribute__((ext_vector_type(4)));
typedef float f32x4 __attribute__((ext_vector_type(4)));
typedef float f32x16 __attribute__((ext_vector_type(16)));
typedef unsigned u32x4 __attribute__((ext_vector_type(4)));
typedef unsigned u32x2 __attribute__((ext_vector_type(2)));

constexpr int BATCH = 2, SEQ = 8192, DM = 4096, DFF = 11008, M = BATCH * SEQ;
constexpr int NH = 16, HD = 128, GW = NH * HD;
constexpr int NQKV = 6 * GW;
constexpr int IN_PROJ = NQKV + NH;
constexpr float EPS = 1e-6f;
constexpr float L2E = 1.4426950408889634f;

__device__ __forceinline__ unsigned cvt_pk_bf16(float lo, float hi) { unsigned r; asm volatile("v_cvt_pk_bf16_f32 %0, %1, %2" : "=v"(r) : "v"(lo), "v"(hi)); return r; }
__device__ __forceinline__ float ld_agent_f32(const float* p) { return __uint_as_float(__hip_atomic_load((const unsigned*)p, __ATOMIC_RELAXED, __HIP_MEMORY_SCOPE_AGENT)); }
__device__ __forceinline__ float rstd_of(float ss) { return __builtin_amdgcn_rsqf(ss * (1.0f / DM) + EPS); }

namespace pg8 {
constexpr int BM = 256, BK = 64, HALF = 128, HTB = HALF * BK * 2, STAGE_BYTES = 8 * HTB, NXCD = 8, WGM = 8;
__host__ __device__ __forceinline__ int lds_byte(int r, int c) { const int st = (r >> 4) * 2 + (c >> 5), rr = r & 15, cc = c & 31, ob = rr * 64 + cc * 2; return st * 1024 + (ob ^ (((ob >> 9) & 1) << 5)); }
__host__ __device__ __forceinline__ void stage_rc(int b, int& R, int& C) { const int st = b / 1024, sb = b % 1024, swz = sb ^ (((sb >> 9) & 1) << 5); R = (st >> 1) * 16 + swz / 64; C = (st & 1) * 32 + (swz % 64) / 2; }
__host__ __device__ __forceinline__ int perm32(int rho) { const int n = rho >> 4, i = rho & 15; return 8 * (i >> 2) + 4 * n + (i & 3); }
struct Unit { int pm, pn; };
struct Gemm { const bf16_t* A; const bf16_t* Bt; int M, N, K; };
__host__ __device__ __forceinline__ size_t img_off(int row, int col, int K) { return ((size_t)((row >> 8) * (K >> 6) + (col >> 6)) * 2 + ((row >> 7) & 1)) * 8192 + (size_t)(lds_byte(row & 127, col & 63) >> 1); }
__host__ __device__ __forceinline__ int perm32inv(int w) { return 16 * ((w >> 2) & 1) + 4 * (w >> 3) + (w & 3); }
__host__ __device__ __forceinline__ size_t img_off_b(int n, int k, int K) { return img_off((n & ~31) + perm32inv(n & 31), k, K); }
struct StaticOrder {
    static constexpr bool DYNAMIC = false;
    int nM, nN, nwg, G, c, wgm;
    __host__ __device__ void init(int M_, int N_, int G_, int c_, int wgm_ = WGM) { nM = M_ / BM; nN = N_ / BM; nwg = nM * nN; G = G_; c = c_; wgm = wgm_; }
    __host__ __device__ bool next(int i, Unit& u) const {
        const long L = (long)i * G + c; if (L >= nwg) return false;
        int wgid = (int)L; { const int q = nwg / NXCD, r = nwg % NXCD, xcd = wgid % NXCD, off = wgid / NXCD; wgid = (xcd < r ? xcd * (q + 1) : r * (q + 1) + (xcd - r) * q) + off; }
        const int nig = wgm * nN, gid = wgid / nig, fm = gid * wgm, gsz = (nM - fm) < wgm ? (nM - fm) : wgm;
        u.pm = fm + ((wgid % nig) % gsz); u.pn = (wgid % nig) / gsz; return true;
    }
    __device__ __forceinline__ void a_ready(const Unit&) const {}
    __device__ __forceinline__ void done(const Unit&) const {}
};
struct DynOrder {
    static constexpr bool DYNAMIC = true;
    unsigned* heads; int per, home; volatile LAS int* slot;
    __device__ __forceinline__ void decode(int id, Unit& u) const { const int q = id / per, off = id - q * per; u.pm = 8 * q + (off & 7); u.pn = off >> 3; }
    __device__ __forceinline__ int pop_from(int k0) const {
        for (int k = k0; k < 8; ++k) { const int q = (home + k) & 7; const unsigned off = __hip_atomic_fetch_add(heads + 64 * q, 1u, __ATOMIC_RELAXED, __HIP_MEMORY_SCOPE_AGENT); if (off < (unsigned)per) return q * per + (int)off; }
        return -1;
    }
    __device__ __forceinline__ bool next(int, Unit&) const { return false; }
    __device__ __forceinline__ void a_ready(const Unit&) const {}
    __device__ __forceinline__ void done(const Unit&) const {}
};


using f32x2 = __attribute__((ext_vector_type(2))) float;
struct EpiSwiglu {
    static constexpr bool PERM = true, AFTER_DRAIN = false;
    bf16_t* H; const float* rowss;
    __device__ __forceinline__ void operator()(const f32x4 (&acc)[2][2][4][2], const Unit& u, int wr, int wc, int fr, int fq) const {
        const int row0 = u.pm * BM + wr * 64 + fr, col0 = u.pn * HALF + wc * 32 + 8 * fq;
        float rs[2][4];
#pragma unroll
        for (int ai = 0; ai < 2; ++ai)
#pragma unroll
            for (int m = 0; m < 4; ++m) rs[ai][m] = ld_agent_f32(rowss + row0 + ai * HALF + m * 16);
#pragma unroll
        for (int ai = 0; ai < 2; ++ai)
#pragma unroll
            for (int m = 0; m < 4; ++m) {
                const int row = row0 + ai * HALF + m * 16; const float r = rstd_of(rs[ai][m]);
                const f32x2 rn = {-L2E * r, -L2E * r}, r2 = {r * r, r * r}; f32x2 t[4], p[4];
#pragma unroll
                for (int k = 0; k < 4; ++k) { const f32x2 g = {acc[ai][0][m][k >> 1][2 * (k & 1)], acc[ai][0][m][k >> 1][2 * (k & 1) + 1]}, up = {acc[ai][1][m][k >> 1][2 * (k & 1)], acc[ai][1][m][k >> 1][2 * (k & 1) + 1]};
                    t[k] = g * rn; p[k] = (g * up) * r2; }
#pragma unroll
                for (int k = 0; k < 4; ++k) { t[k].x = __builtin_amdgcn_exp2f(t[k].x); t[k].y = __builtin_amdgcn_exp2f(t[k].y); }
#pragma unroll
                for (int k = 0; k < 4; ++k) t[k] = t[k] + (f32x2){1.0f, 1.0f};
#pragma unroll
                for (int k = 0; k < 4; ++k) { t[k].x = __builtin_amdgcn_rcpf(t[k].x); t[k].y = __builtin_amdgcn_rcpf(t[k].y); }
#pragma unroll
                for (int k = 0; k < 4; ++k) p[k] = p[k] * t[k];
                u32x4 w; w.x = cvt_pk_bf16(p[0].x, p[0].y); w.y = cvt_pk_bf16(p[1].x, p[1].y); w.z = cvt_pk_bf16(p[2].x, p[2].y); w.w = cvt_pk_bf16(p[3].x, p[3].y);
                *(u32x4*)(H + img_off(row, col0, DFF)) = w; }
    }
};
template <bool BASE_BF16, bool OUT_F32>
struct EpiResid {
    static constexpr bool PERM = true, AFTER_DRAIN = false;
    const void* base; void* out; float* rowss; float scale;
    __device__ __forceinline__ void operator()(const f32x4 (&acc)[2][2][4][2], const Unit& u, int wr, int wc, int fr, int fq) const {
        const int row0 = u.pm * BM + wr * 64 + fr, col0 = u.pn * BM + wc * 32 + 8 * fq;
#pragma unroll
        for (int ai = 0; ai < 2; ++ai) {
            f32x4 bv[4][2][2];
#pragma unroll
            for (int m = 0; m < 4; ++m) { const int row = row0 + ai * HALF + m * 16; const size_t off = (size_t)row * DM + col0;
#pragma unroll
                for (int bj = 0; bj < 2; ++bj) {
                    if (BASE_BF16) { const u32x4 w = *(const u32x4*)((const bf16_t*)base + img_off(row, col0 + bj * HALF, DM));
                        bv[m][bj][0] = (f32x4){__uint_as_float(w.x << 16), __uint_as_float(w.x & 0xffff0000u), __uint_as_float(w.y << 16), __uint_as_float(w.y & 0xffff0000u)};
                        bv[m][bj][1] = (f32x4){__uint_as_float(w.z << 16), __uint_as_float(w.z & 0xffff0000u), __uint_as_float(w.w << 16), __uint_as_float(w.w & 0xffff0000u)}; }
                    else { bv[m][bj][0] = *(const f32x4*)((const float*)base + off + bj * HALF); bv[m][bj][1] = *(const f32x4*)((const float*)base + off + bj * HALF + 4); } } }
            asm volatile("" ::: "memory");
#pragma unroll
            for (int m = 0; m < 4; ++m) {
                const int row = row0 + ai * HALF + m * 16; const size_t off = (size_t)row * DM + col0; float ss = 0.f;
#pragma unroll
                for (int bj = 0; bj < 2; ++bj) {
                    const f32x4 v0 = bv[m][bj][0] + acc[ai][bj][m][0] * scale, v1 = bv[m][bj][1] + acc[ai][bj][m][1] * scale;
                    ss += (v0[0] * v0[0] + v0[1] * v0[1]) + (v0[2] * v0[2] + v0[3] * v0[3]) + (v1[0] * v1[0] + v1[1] * v1[1]) + (v1[2] * v1[2] + v1[3] * v1[3]);
                    if (OUT_F32) { *(f32x4*)((float*)out + off + bj * HALF) = v0; *(f32x4*)((float*)out + off + bj * HALF + 4) = v1; }
                    else { u32x4 w; w.x = cvt_pk_bf16(v0[0], v0[1]); w.y = cvt_pk_bf16(v0[2], v0[3]); w.z = cvt_pk_bf16(v1[0], v1[1]); w.w = cvt_pk_bf16(v1[2], v1[3]);
                        *(u32x4*)((bf16_t*)out + img_off(row, col0 + bj * HALF, DM)) = w; } }
                ss += __shfl_xor(ss, 16); ss += __shfl_xor(ss, 32);
                if (fq == 0) __hip_atomic_fetch_add(rowss + row, ss, __ATOMIC_RELAXED, __HIP_MEMORY_SCOPE_AGENT); }
        }
    }
};
struct EpiResidNorm {
    static constexpr bool PERM = true, AFTER_DRAIN = false;
    const bf16_t* base; float* out; float* rowss; unsigned* cnt; const float* gain; float scale;
    __device__ __forceinline__ void operator()(const f32x4 (&acc_c)[2][2][4][2], const Unit& u, int wr, int wc, int fr, int fq) const {
        f32x4 (&acc)[2][2][4][2] = const_cast<f32x4 (&)[2][2][4][2]>(acc_c);
        const int row0 = u.pm * BM + wr * 64 + fr, col0 = u.pn * BM + wc * 32 + 8 * fq;
#pragma unroll
        for (int ai = 0; ai < 2; ++ai) {
            u32x4 bw[4][2];
#pragma unroll
            for (int m = 0; m < 4; ++m) {
#pragma unroll
                for (int bj = 0; bj < 2; ++bj) bw[m][bj] = *(const u32x4*)(base + img_off(row0 + ai * HALF + m * 16, col0 + bj * HALF, DM)); }
#pragma unroll
            for (int m = 0; m < 4; ++m) { float ss = 0.f;
#pragma unroll
                for (int bj = 0; bj < 2; ++bj) { const u32x4 w = bw[m][bj];
                    const f32x4 b0 = {__uint_as_float(w.x << 16), __uint_as_float(w.x & 0xffff0000u), __uint_as_float(w.y << 16), __uint_as_float(w.y & 0xffff0000u)};
                    const f32x4 b1 = {__uint_as_float(w.z << 16), __uint_as_float(w.z & 0xffff0000u), __uint_as_float(w.w << 16), __uint_as_float(w.w & 0xffff0000u)};
                    const f32x4 v0 = b0 + acc[ai][bj][m][0] * scale, v1 = b1 + acc[ai][bj][m][1] * scale; acc[ai][bj][m][0] = v0; acc[ai][bj][m][1] = v1;
                    ss += (v0[0] * v0[0] + v0[1] * v0[1]) + (v0[2] * v0[2] + v0[3] * v0[3]) + (v1[0] * v1[0] + v1[1] * v1[1]) + (v1[2] * v1[2] + v1[3] * v1[3]); }
                ss += __shfl_xor(ss, 16); ss += __shfl_xor(ss, 32);
                if (fq == 0) __hip_atomic_fetch_add(rowss + row0 + ai * HALF + m * 16, ss, __ATOMIC_RELAXED, __HIP_MEMORY_SCOPE_AGENT); }
        }
        asm volatile("s_waitcnt vmcnt(0)" ::: "memory");
        unsigned* pc = cnt + 64 * u.pm;
        if (fr == 0 && fq == 0) __hip_atomic_fetch_add(pc, 1u, __ATOMIC_RELAXED, __HIP_MEMORY_SCOPE_AGENT);
        { unsigned spins = 0;
          while ((unsigned)__builtin_amdgcn_readfirstlane(__hip_atomic_load(pc, __ATOMIC_RELAXED, __HIP_MEMORY_SCOPE_AGENT)) < 128u) { __builtin_amdgcn_s_sleep(2); if (++spins > (1u << 22)) break; } }
        f32x4 g0[2], g1[2];
#pragma unroll
        for (int bj = 0; bj < 2; ++bj) { g0[bj] = *(const f32x4*)(gain + col0 + bj * HALF); g1[bj] = *(const f32x4*)(gain + col0 + bj * HALF + 4); }
        float rs[2][4];
#pragma unroll
        for (int ai = 0; ai < 2; ++ai)
#pragma unroll
            for (int m = 0; m < 4; ++m) rs[ai][m] = ld_agent_f32(rowss + row0 + ai * HALF + m * 16);
#pragma unroll
        for (int ai = 0; ai < 2; ++ai)
#pragma unroll
            for (int m = 0; m < 4; ++m) { const int row = row0 + ai * HALF + m * 16; const float r = rstd_of(rs[ai][m]); float* op = out + (size_t)row * DM + col0;
#pragma unroll
                for (int bj = 0; bj < 2; ++bj) { *(f32x4*)(op + bj * HALF) = acc[ai][bj][m][0] * r * g0[bj]; *(f32x4*)(op + bj * HALF + 4) = acc[ai][bj][m][1] * r * g1[bj]; } }
    }
};
struct EpiQKV {
    static constexpr bool PERM = true, AFTER_DRAIN = false;
    bf16_t* O; const float* rowss; float* tmx;
    __device__ __forceinline__ void operator()(const f32x4 (&acc)[2][2][4][2], const Unit& u, int wr, int wc, int fr, int fq) const {
        const int row0 = u.pm * BM + wr * 64 + fr; const int colt = u.pn * BM, t = colt >> 11, cin = colt & (GW - 1);
        bf16_t* basep = O + (size_t)t * ((size_t)M * GW) + cin + wc * 32 + 8 * fq;
        float rs[2][4];
#pragma unroll
        for (int ai = 0; ai < 2; ++ai)
#pragma unroll
            for (int m = 0; m < 4; ++m) rs[ai][m] = rstd_of(ld_agent_f32(rowss + row0 + ai * HALF + m * 16));
#pragma unroll
        for (int ai = 0; ai < 2; ++ai)
#pragma unroll
            for (int m = 0; m < 4; ++m) {
                const int row = row0 + ai * HALF + m * 16; const float r = rs[ai][m]; bf16_t* rowp = basep + (size_t)row * GW;
#pragma unroll
                for (int bj = 0; bj < 2; ++bj) { const f32x4 v0 = acc[ai][bj][m][0] * r, v1 = acc[ai][bj][m][1] * r;
                    u32x4 w; w.x = cvt_pk_bf16(v0[0], v0[1]); w.y = cvt_pk_bf16(v0[2], v0[3]); w.z = cvt_pk_bf16(v1[0], v1[1]); w.w = cvt_pk_bf16(v1[2], v1[3]);
                    *(u32x4*)(rowp + bj * HALF) = w; } }
        if (t == 4) {
#pragma unroll
            for (int ai = 0; ai < 2; ++ai)
#pragma unroll
                for (int bj = 0; bj < 2; ++bj) {
                    float mx = 0.f;
#pragma unroll
                    for (int m = 0; m < 4; ++m) { const f32x4 v0 = acc[ai][bj][m][0] * rs[ai][m], v1 = acc[ai][bj][m][1] * rs[ai][m];
                        float s = (v0[0] * v0[0] + v0[1] * v0[1]) + (v0[2] * v0[2] + v0[3] * v0[3]) + (v1[0] * v1[0] + v1[1] * v1[1]) + (v1[2] * v1[2] + v1[3] * v1[3]);
                        s += __shfl_xor(s, 16); s += __shfl_xor(s, 32); mx = fmaxf(mx, s); }
                    mx = fmaxf(mx, __shfl_xor(mx, 1)); mx = fmaxf(mx, __shfl_xor(mx, 2)); mx = fmaxf(mx, __shfl_xor(mx, 4)); mx = fmaxf(mx, __shfl_xor(mx, 8));
                    const int rowt = u.pm * BM + ai * HALF + wr * 64, bb = rowt / SEQ, tile = (rowt % SEQ) >> 6, head = (cin >> 7) + bj;
                    if (fr == 0 && fq == 0) __hip_atomic_fetch_add(tmx + (bb * NH + head) * 128 + tile, mx, __ATOMIC_RELAXED, __HIP_MEMORY_SCOPE_AGENT); }
        }
    }
};

template <class Epi, class Sched, bool ALIGN_EPI = false, bool SP2 = false>
__device__ __forceinline__ void gemm_phase(LAS unsigned char* lds, const Gemm g, const Sched& S, const Epi& E) {
    const int tid = threadIdx.x, wid = __builtin_amdgcn_readfirstlane(tid >> 6), lane = tid & 63, wr = wid >> 2, wc = wid & 3, fr = lane & 15, fq = lane >> 4;
    const int K = g.K, nt = K / BK;
    static_assert(Epi::PERM, "the B images are stored with the perm32 row order");
    unsigned voffA[2], voffB[2];
#pragma unroll
    for (int i = 0; i < 2; ++i) { voffA[i] = (unsigned)(tid * 16 + i * 8192); voffB[i] = voffA[i]; }
    const size_t kstep = (size_t)(BM * BK * 2);
    const size_t hstep = (size_t)(HALF * BK * 2);
    const size_t tstep = (size_t)BM * K * 2;
    const unsigned ldsw = (unsigned)wid * 1024u;
    const int aoff = lds_byte(wr * 64 + fr, fq * 8), boff = lds_byte(wc * 32 + fr, fq * 8);
#define PG8_SA(b, h) (((b) * 2 + (h)) * HTB)
#define PG8_SB(b, h) ((4 + (b) * 2 + (h)) * HTB)
    const unsigned ldsbase = (unsigned)__builtin_amdgcn_readfirstlane((int)((unsigned)(uintptr_t)lds + ldsw));
#define PG8_STAGE(bufoff, gbase, voff) do { _Pragma("unroll") for (int _i = 0; _i < 2; ++_i) { \
        asm volatile("s_add_i32 m0, %2, %3\n\ts_nop 0\n\tglobal_load_lds_dwordx4 %0, %1" \
                     :: "v"((voff)[_i]), "s"((const void*)(gbase)), "s"(ldsbase), "n"((bufoff) + _i * 8192) : "memory", "m0", "scc"); } } while (0)
#define PG8_LDA(dst, b, h) do { _Pragma("unroll") for (int m = 0; m < 4; ++m) _Pragma("unroll") for (int k = 0; k < 2; ++k) dst[m][k] = *(const LAS bf16x8*)(lds + PG8_SA(b, h) + aoff + m * 2048 + k * 1024); } while (0)
#define PG8_LDB(dst, b, h) do { _Pragma("unroll") for (int n = 0; n < 2; ++n) _Pragma("unroll") for (int k = 0; k < 2; ++k) dst[n][k] = *(const LAS bf16x8*)(lds + PG8_SB(b, h) + boff + n * 2048 + k * 1024); } while (0)
#define PG8_MMA(ai, bj, At, Bt) do { __builtin_amdgcn_s_setprio(1); _Pragma("unroll") for (int m = 0; m < 4; ++m) _Pragma("unroll") for (int n = 0; n < 2; ++n) _Pragma("unroll") for (int k = 0; k < 2; ++k) \
        acc[ai][bj][m][n] = __builtin_amdgcn_mfma_f32_16x16x32_bf16(Bt[n][k], At[m][k], acc[ai][bj][m][n], 0, 0, 0); __builtin_amdgcn_s_setprio(0); } while (0)
#define PG8_WAIT_V(n) asm volatile("s_waitcnt vmcnt(" #n ")" ::: "memory")
#define PG8_WAIT_L(n) asm volatile("s_waitcnt lgkmcnt(" #n ")" ::: "memory")
#define PG8_BAR __builtin_amdgcn_s_barrier()
#define PG8_SCHED __builtin_amdgcn_sched_barrier(0)
    Unit cur, nxt; int ui = 0;
    if constexpr (Sched::DYNAMIC) {
        if (tid == 0) S.slot[0] = S.pop_from(0);
        __syncthreads();
        const int id0 = S.slot[0]; if (id0 < 0) return;
        S.decode(id0, cur);
    } else { if (!S.next(0, cur)) return; }
    f32x4 acc[2][2][4][2];
#pragma unroll
    for (int a = 0; a < 2; ++a)
#pragma unroll
        for (int b = 0; b < 2; ++b)
#pragma unroll
            for (int m = 0; m < 4; ++m)
#pragma unroll
                for (int n = 0; n < 2; ++n) acc[a][b][m][n] = (f32x4){0.f, 0.f, 0.f, 0.f};
    bf16x8 At[4][2], B0[2][2], B1[2][2];
    const char* cA = (const char*)g.A + (size_t)cur.pm * tstep; const char* cB = (const char*)g.Bt + (size_t)cur.pn * tstep;
    S.a_ready(cur);
    if constexpr (SP2) {
        PG8_STAGE(PG8_SB(0, 0), cB, voffB); PG8_STAGE(PG8_SB(0, 1), cB + hstep, voffB); PG8_STAGE(PG8_SA(0, 0), cA, voffA); PG8_STAGE(PG8_SA(0, 1), cA + hstep, voffA);
        if (wr == 1) PG8_BAR;
        PG8_WAIT_V(2); PG8_BAR;
        PG8_STAGE(PG8_SB(1, 0), cB + kstep, voffB); PG8_STAGE(PG8_SA(1, 0), cA + kstep, voffA); PG8_STAGE(PG8_SB(1, 1), cB + hstep + kstep, voffB);
        PG8_WAIT_V(6); PG8_BAR;
    } else {
        PG8_STAGE(PG8_SB(0, 0), cB, voffB); PG8_STAGE(PG8_SA(0, 0), cA, voffA); PG8_STAGE(PG8_SB(0, 1), cB + hstep, voffB); PG8_STAGE(PG8_SA(0, 1), cA + hstep, voffA);
        if (wr == 1) PG8_BAR;
        PG8_WAIT_V(4); PG8_BAR;
        PG8_STAGE(PG8_SB(1, 0), cB + kstep, voffB); PG8_STAGE(PG8_SA(1, 0), cA + kstep, voffA); PG8_STAGE(PG8_SB(1, 1), cB + hstep + kstep, voffB);
        PG8_WAIT_V(6); PG8_BAR;
    }
    for (;;) {
        bool has_next = false; const char* nA = cA; const char* nB = cB; unsigned popv = 0;
        if constexpr (!Sched::DYNAMIC) { has_next = S.next(ui + 1, nxt); if (has_next) { nA = (const char*)g.A + (size_t)nxt.pm * tstep; nB = (const char*)g.Bt + (size_t)nxt.pn * tstep; } }
        for (int t = 0; t < nt; t += 2) {
            const bool last = (t == nt - 2);
            if constexpr (Sched::DYNAMIC) {
                if (t == nt - 6 && tid == 0) asm volatile("global_atomic_add %0, %1, %2, %3 sc0" : "=v"(popv) : "v"(0u), "v"(1u), "s"(S.heads + 64 * S.home) : "memory");
                if (t == nt - 4 && tid == 0) S.slot[(ui + 1) & 1] = (popv < (unsigned)S.per) ? S.home * S.per + (int)popv : S.pop_from(1);
                if (last) { const int idn = S.slot[(ui + 1) & 1]; has_next = idn >= 0; if (has_next) { S.decode(idn, nxt); nA = (const char*)g.A + (size_t)nxt.pm * tstep; nB = (const char*)g.Bt + (size_t)nxt.pn * tstep; } }
            }
            const char* a1 = cA + (size_t)(t + 1) * kstep;
            const char* a2 = last ? nA : cA + (size_t)(t + 2) * kstep; const char* b2 = last ? nB : cB + (size_t)(t + 2) * kstep;
            const char* a3 = a2 + kstep; const char* b3 = b2 + kstep;
            if (last && has_next) S.a_ready(nxt);
            if constexpr (SP2) {
            PG8_LDB(B0, 0, 0); PG8_LDB(B1, 0, 1); PG8_SCHED; PG8_LDA(At, 0, 0); PG8_STAGE(PG8_SA(1, 1), a1 + hstep, voffA);
            PG8_WAIT_V(8); PG8_WAIT_L(0); PG8_BAR; PG8_MMA(0, 0, At, B0); PG8_MMA(0, 1, At, B1); PG8_BAR; PG8_SCHED;
            PG8_LDA(At, 0, 1); PG8_STAGE(PG8_SB(0, 0), b2, voffB); PG8_STAGE(PG8_SB(0, 1), b2 + hstep, voffB); PG8_STAGE(PG8_SA(0, 0), a2, voffA);
            PG8_WAIT_V(8); PG8_WAIT_L(0); PG8_BAR; PG8_MMA(1, 0, At, B0); PG8_MMA(1, 1, At, B1); PG8_BAR; PG8_SCHED;
            PG8_LDB(B0, 1, 0); PG8_LDB(B1, 1, 1); PG8_SCHED; PG8_LDA(At, 1, 0); PG8_STAGE(PG8_SA(0, 1), a2 + hstep, voffA);
            PG8_WAIT_V(8); PG8_WAIT_L(0); PG8_BAR; PG8_MMA(0, 0, At, B0); PG8_MMA(0, 1, At, B1); PG8_BAR; PG8_SCHED;
            PG8_LDA(At, 1, 1); PG8_STAGE(PG8_SB(1, 0), b3, voffB); PG8_STAGE(PG8_SB(1, 1), b3 + hstep, voffB); PG8_STAGE(PG8_SA(1, 0), a3, voffA);
            PG8_WAIT_V(8); PG8_WAIT_L(0); PG8_BAR; PG8_MMA(1, 0, At, B0); PG8_MMA(1, 1, At, B1); PG8_BAR; PG8_SCHED;
            } else {
            PG8_LDB(B0, 0, 0); PG8_SCHED; PG8_LDA(At, 0, 0); PG8_STAGE(PG8_SA(1, 1), a1 + hstep, voffA);
            PG8_WAIT_L(8); PG8_BAR; PG8_WAIT_L(0); PG8_MMA(0, 0, At, B0); PG8_BAR; PG8_SCHED;
            PG8_LDB(B1, 0, 1); PG8_STAGE(PG8_SB(0, 0), b2, voffB);
            PG8_BAR; PG8_WAIT_L(0); PG8_MMA(0, 1, At, B1); PG8_BAR;
            PG8_LDA(At, 0, 1); PG8_STAGE(PG8_SA(0, 0), a2, voffA);
            PG8_BAR; PG8_WAIT_L(0); PG8_MMA(1, 0, At, B0); PG8_BAR; PG8_SCHED;
            PG8_STAGE(PG8_SB(0, 1), b2 + hstep, voffB);
            PG8_WAIT_V(6); PG8_BAR; PG8_MMA(1, 1, At, B1); PG8_BAR;
            PG8_LDB(B0, 1, 0); PG8_SCHED; PG8_LDA(At, 1, 0); PG8_STAGE(PG8_SA(0, 1), a2 + hstep, voffA);
            PG8_WAIT_L(8); PG8_BAR; PG8_WAIT_L(0); PG8_MMA(0, 0, At, B0); PG8_BAR; PG8_SCHED;
            PG8_LDB(B1, 1, 1); PG8_STAGE(PG8_SB(1, 0), b3, voffB);
            PG8_BAR; PG8_WAIT_L(0); PG8_MMA(0, 1, At, B1); PG8_BAR;
            PG8_LDA(At, 1, 1); PG8_STAGE(PG8_SA(1, 0), a3, voffA);
            PG8_BAR; PG8_WAIT_L(0); PG8_MMA(1, 0, At, B0); PG8_BAR; PG8_SCHED;
            PG8_STAGE(PG8_SB(1, 1), b3 + hstep, voffB);
            PG8_WAIT_V(6); PG8_BAR; PG8_MMA(1, 1, At, B1); PG8_BAR;
            }
        }
        if constexpr (ALIGN_EPI) { if (wr == 0) PG8_BAR; }
        if constexpr (!Epi::AFTER_DRAIN) { E(acc, cur, wr, wc, fr, fq); S.done(cur); }
        if (!has_next) break;
#pragma unroll
        for (int a = 0; a < 2; ++a)
#pragma unroll
            for (int b = 0; b < 2; ++b)
#pragma unroll
                for (int m = 0; m < 4; ++m)
#pragma unroll
                    for (int n = 0; n < 2; ++n) acc[a][b][m][n] = (f32x4){0.f, 0.f, 0.f, 0.f};
        cur = nxt; cA = nA; cB = nB; ++ui;
        if constexpr (ALIGN_EPI) { if (wr == 1) PG8_BAR; }
    }
    PG8_WAIT_V(0);
    if constexpr (!ALIGN_EPI) { if (wr == 0) PG8_BAR; }
    PG8_BAR;
#undef PG8_SA
#undef PG8_SB
#undef PG8_STAGE
#undef PG8_LDA
#undef PG8_LDB
#undef PG8_MMA
#undef PG8_WAIT_V
#undef PG8_WAIT_L
#undef PG8_BAR
#undef PG8_SCHED
}
}

namespace att {
constexpr int PITCH = GW, QB = 256, KVBLK = 64, SHM = 16384;
constexpr float SCALE = 0.08838834764831845f;
constexpr float C2 = SCALE * L2E;
constexpr int OFF_K = 65536, OFF_WS = 114688, OFF_CB = 116736, OFF_KP = 117248, OFF_CLB = 117760, OFF_VOTE = 118528, OFF_SLOT = 118592, ATT_LDS_BYTES = 118592 + 64;
#define KSWZ(row, colB) ((row) * 256 + ((colB) ^ (((row) & 7) << 4)))
#define SBAR() __builtin_amdgcn_sched_barrier(0)
__device__ __forceinline__ int v_st(int k, int c) { const int kk = (k & ~0xC) | ((k & 4) << 1) | ((k & 8) >> 1); return ((kk >> 3) * 4 + (c >> 5)) * 512 + ((kk & 7) * 32 + (c & 31)) * 2; }
__device__ __forceinline__ int v_rd_base(int lane) { return ((lane & 3) << 3) | (((lane >> 2) & 3) << 6) | (((lane >> 4) & 1) << 5) | (((lane >> 5) & 1) << 8); }
constexpr int v_rd_off(int d0, int ks, int half) { return d0 * 512 + ks * 4096 + half * 2048; }
__device__ __forceinline__ int crow(int r, int hi) { return (r & 3) + 8 * (r >> 2) + 4 * hi; }
__device__ __forceinline__ float partner(float x, int hi) { auto rr = __builtin_amdgcn_permlane32_swap(__float_as_uint(x), __float_as_uint(x), false, false); return __uint_as_float(hi ? rr[0] : rr[1]); }

__device__ __forceinline__ void qkt(f32x16& p0, f32x16& p1, LAS const unsigned char* Kt, int r32, int hi, const bf16x8* qr) {
    LAS const unsigned char* kb[4];
#pragma unroll
    for (int dd = 0; dd < 4; ++dd) kb[dd] = Kt + KSWZ(r32, (dd * 16 + hi * 8) * 2);
#pragma unroll
    for (int d0 = 0; d0 < 8; ++d0) { LAS const unsigned char* a = kb[d0 & 3] + (d0 >> 2) * 128;
        const bf16x8 b0 = *(LAS const bf16x8*)a;
        const bf16x8 b1 = *(LAS const bf16x8*)(a + 32 * 256);
        p0 = __builtin_amdgcn_mfma_f32_32x32x16_bf16(b0, qr[d0], p0, 0, 0, 0);
        p1 = __builtin_amdgcn_mfma_f32_32x32x16_bf16(b1, qr[d0], p1, 0, 0, 0); }
}
__device__ __forceinline__ void pv_tile(f32x16* o, int vb0, bf16x8 pa0, bf16x8 pa1, bf16x8 pa2, bf16x8 pa3) {
#define TRRD(dst, off) asm volatile("ds_read_b64_tr_b16 %0, %1 offset:%2" : "=&v"(dst) : "v"(vb0), "i"(off) : "memory")
#define PV_D0(d0) do { s16x4 l0, l1, l2, l3, h0, h1, h2, h3; constexpr int b_ = v_rd_off(d0, 0, 0); \
        TRRD(l0, b_); TRRD(h0, b_ + 2048); TRRD(l1, b_ + 4096); TRRD(h1, b_ + 6144); TRRD(l2, b_ + 8192); TRRD(h2, b_ + 10240); TRRD(l3, b_ + 12288); TRRD(h3, b_ + 14336); \
        asm volatile("s_waitcnt lgkmcnt(0)" ::: "memory"); SBAR(); \
        o[d0] = __builtin_amdgcn_mfma_f32_32x32x16_bf16(pa0, (bf16x8){l0[0], l0[1], l0[2], l0[3], h0[0], h0[1], h0[2], h0[3]}, o[d0], 0, 0, 0); \
        o[d0] = __builtin_amdgcn_mfma_f32_32x32x16_bf16(pa1, (bf16x8){l1[0], l1[1], l1[2], l1[3], h1[0], h1[1], h1[2], h1[3]}, o[d0], 0, 0, 0); \
        o[d0] = __builtin_amdgcn_mfma_f32_32x32x16_bf16(pa2, (bf16x8){l2[0], l2[1], l2[2], l2[3], h2[0], h2[1], h2[2], h2[3]}, o[d0], 0, 0, 0); \
        o[d0] = __builtin_amdgcn_mfma_f32_32x32x16_bf16(pa3, (bf16x8){l3[0], l3[1], l3[2], l3[3], h3[0], h3[1], h3[2], h3[3]}, o[d0], 0, 0, 0); } while (0)
    PV_D0(0); PV_D0(1); PV_D0(2); PV_D0(3);
#undef PV_D0
#undef TRRD
}
__device__ __forceinline__ void pack_p(const f32x16& p0, const f32x16& p1, bf16x8& pa0, bf16x8& pa1, bf16x8& pa2, bf16x8& pa3) {
#define PK4(P, B_, OUT) do { unsigned a0 = cvt_pk_bf16(P[B_+0], P[B_+1]), a1 = cvt_pk_bf16(P[B_+2], P[B_+3]); \
        unsigned b0 = cvt_pk_bf16(P[B_+4], P[B_+5]), b1 = cvt_pk_bf16(P[B_+6], P[B_+7]); \
        auto r0 = __builtin_amdgcn_permlane32_swap(a0, b0, false, false); auto r1 = __builtin_amdgcn_permlane32_swap(a1, b1, false, false); \
        u32x4 w = {r0[0], r1[0], r0[1], r1[1]}; OUT = __builtin_bit_cast(bf16x8, w); } while (0)
    PK4(p0, 0, pa0); PK4(p0, 8, pa1); PK4(p1, 0, pa2); PK4(p1, 8, pa3);
#undef PK4
}
template <bool NORM_L>
__device__ __forceinline__ void head_epilogue(f32x16* o, float l_own, LAS unsigned char* lds, int wid, int r32, int hi, const float* gain, bf16_t* Mrg, int grow0  , int gcol0  ) {
    LAS float* li_l = (LAS float*)(lds + OFF_WS) + wid * 64;
    if (NORM_L) {
        const float l = l_own + partner(l_own, hi);
        if (hi == 0) li_l[r32] = l;
        asm volatile("s_waitcnt lgkmcnt(0)" ::: "memory");
#pragma unroll
        for (int r = 0; r < 16; ++r) { const float rl = __builtin_amdgcn_rcpf(li_l[crow(r, hi)]);
#pragma unroll
            for (int d0 = 0; d0 < 4; ++d0) o[d0][r] *= rl; }
    }
    float gv[4];
#pragma unroll
    for (int d0 = 0; d0 < 4; ++d0) gv[d0] = gain[d0 * 32 + r32];
#pragma unroll
    for (int r = 0; r < 16; ++r) {
        float ss = (o[0][r] * o[0][r] + o[1][r] * o[1][r]) + (o[2][r] * o[2][r] + o[3][r] * o[3][r]);
        ss += __shfl_xor(ss, 1); ss += __shfl_xor(ss, 2); ss += __shfl_xor(ss, 4); ss += __shfl_xor(ss, 8); ss += __shfl_xor(ss, 16);
        const float rn = __builtin_amdgcn_rsqf(ss * (1.0f / HD) + EPS);
        const int orow = crow(r, hi);
#pragma unroll
        for (int d0 = 0; d0 < 4; ++d0) { const float v = o[d0][r] * rn * gv[d0]; const float vn = __shfl_xor(v, 1);
            if ((r32 & 1) == 0) *(unsigned*)(Mrg + pg8::img_off(grow0 + orow, gcol0 + d0 * 32 + r32, DM)) = cvt_pk_bf16(v, vn); }
    }
}

__device__ __forceinline__ void sb_part1(f32x16& p0, f32x16& p1, float& R, bool diag, int dq, int hi) {
    float sp0[16], sp1[16];
#pragma unroll
    for (int r = 0; r < 16; ++r) { const int c_ = (r & 3) + 8 * (r >> 2);
        float y0 = fminf(p0[r] * C2, 100.f), y1 = fminf(p1[r] * C2, 100.f);
        float s0 = __builtin_amdgcn_logf(1.0f + __builtin_amdgcn_exp2f(y0)), s1 = __builtin_amdgcn_logf(1.0f + __builtin_amdgcn_exp2f(y1));
        sp0[r] = s0; sp1[r] = s1; p0[r] = y0 - s0; p1[r] = y1 - s1; (void)c_; }
    if (diag) {
        asm volatile("; diagonal tile" ::: "memory");
#pragma unroll
        for (int r = 0; r < 16; ++r) { const int c_ = (r & 3) + 8 * (r >> 2);
            if (!(c_ < dq)) { sp0[r] = 0.f; p0[r] = -__builtin_inff(); } if (!(c_ + 32 < dq)) { sp1[r] = 0.f; p1[r] = -__builtin_inff(); } } }
    float G_[8], T_[8];
#pragma unroll
    for (int g = 0; g < 4; ++g) { G_[g] = (sp0[4 * g] + sp0[4 * g + 1]) + (sp0[4 * g + 2] + sp0[4 * g + 3]); G_[4 + g] = (sp1[4 * g] + sp1[4 * g + 1]) + (sp1[4 * g + 2] + sp1[4 * g + 3]); }
    T_[7] = 0.f;
#pragma unroll
    for (int g = 6; g >= 0; --g) T_[g] = T_[g + 1] + G_[g + 1];
    const float tot_ = T_[0] + G_[0];
#pragma unroll
    for (int g = 0; g < 8; ++g) { const float send_ = T_[g] + (hi ? G_[g] : 0.f); T_[g] = R + T_[g] + partner(send_, hi); }
    R += tot_ + partner(tot_, hi);
#pragma unroll
    for (int g = 0; g < 4; ++g) {
        float s3 = T_[g], s2 = s3 + sp0[4 * g + 3], s1_ = s2 + sp0[4 * g + 2], s0_ = s1_ + sp0[4 * g + 1];
        p0[4 * g + 3] -= s3; p0[4 * g + 2] -= s2; p0[4 * g + 1] -= s1_; p0[4 * g] -= s0_;
        s3 = T_[4 + g]; s2 = s3 + sp1[4 * g + 3]; s1_ = s2 + sp1[4 * g + 2]; s0_ = s1_ + sp1[4 * g + 1];
        p1[4 * g + 3] -= s3; p1[4 * g + 2] -= s2; p1[4 * g + 1] -= s1_; p1[4 * g] -= s0_; }
}
__device__ __forceinline__ void sb_finish(f32x16& p0, f32x16& p1, bf16x8& pa0, bf16x8& pa1, bf16x8& pa2, bf16x8& pa3) {
#pragma unroll
    for (int r = 0; r < 16; ++r) { p0[r] = __builtin_amdgcn_exp2f(p0[r]); p1[r] = __builtin_amdgcn_exp2f(p1[r]); }
    pack_p(p0, p1, pa0, pa1, pa2, pa3);
}
__device__ __forceinline__ void fox_part1(f32x16& p0, f32x16& p1, float& m_reg, float& alpha, bool diag, int dq, int hi) {
    if (diag) {
        asm volatile("; diagonal tile" ::: "memory");
#pragma unroll
        for (int r = 0; r < 16; ++r) { const int c_ = (r & 3) + 8 * (r >> 2); if (!(c_ <= dq)) p0[r] = -__builtin_inff(); if (!(c_ + 32 <= dq)) p1[r] = -__builtin_inff(); } }
    float pmax = p0[0];
#pragma unroll
    for (int r = 1; r < 16; ++r) pmax = fmaxf(pmax, p0[r]);
#pragma unroll
    for (int r = 0; r < 16; ++r) pmax = fmaxf(pmax, p1[r]);
    pmax = fmaxf(pmax, partner(pmax, hi));
    if (__all((pmax - m_reg) * SCALE <= 8.0f)) alpha = 1.f;
    else { const float mn = fmaxf(m_reg, pmax); alpha = __builtin_amdgcn_exp2f((m_reg - mn) * C2); m_reg = mn; }
    const float mnL = -m_reg * C2;
#pragma unroll
    for (int r = 0; r < 16; ++r) { p0[r] = fmaf(p0[r], C2, mnL); p1[r] = fmaf(p1[r], C2, mnL); }
#pragma unroll
    for (int r = 0; r < 16; ++r) p0[r] = __builtin_amdgcn_exp2f(p0[r]);
}
__device__ __forceinline__ void fox_finish(f32x16& p0, f32x16& p1, float alpha, float& l_reg, bf16x8& pa0, bf16x8& pa1, bf16x8& pa2, bf16x8& pa3) {
#pragma unroll
    for (int r = 0; r < 16; ++r) p1[r] = __builtin_amdgcn_exp2f(p1[r]);
    float ps = 0.f;
#pragma unroll
    for (int r = 0; r < 16; ++r) ps += p0[r] + p1[r];
    l_reg = l_reg * alpha + ps;
    pack_p(p0, p1, pa0, pa1, pa2, pa3);
}

template <int TYPE>
__device__ __forceinline__ void attn_block(const bf16_t* Qg, const bf16_t* Kg, const bf16_t* Vg, bf16_t* Mrg, int grow_b  , int gcol0  , const float* gain, const float* clr, int P0, LAS unsigned char* lds) {
    const int tid = threadIdx.x, wid = __builtin_amdgcn_readfirstlane(tid >> 6), lane = tid & 63, r32 = lane & 31, hi = lane >> 5;
    const int qlo = P0 + wid * 32, qpos = qlo + r32;
    bf16x8 qr[8];
#pragma unroll
    for (int d0 = 0; d0 < 8; ++d0) qr[d0] = *(const bf16x8*)(Qg + (size_t)qpos * PITCH + d0 * 16 + hi * 8);
    const int NT = P0 / KVBLK + 4;
    const int sr = tid >> 4, sc = (tid & 15) * 8, vst0 = v_st(sr, sc), vst1 = v_st(32 + sr, sc), kws = KSWZ(sr, sc * 2);
    const int vbase = (int)(unsigned)(uintptr_t)lds + v_rd_base(lane);
    LAS volatile int* vote = (LAS volatile int*)(lds + OFF_VOTE);
    LAS const float* CB = (LAS const float*)(lds + OFF_CB);
    LAS const float* KP = (LAS const float*)(lds + OFF_KP);
    LAS float* CLB = (LAS float*)(lds + OFF_CLB);
    LAS float* al_l = (LAS float*)(lds + OFF_WS) + wid * 64 + 32;
    f32x16 o[4];
#pragma unroll
    for (int d0 = 0; d0 < 4; ++d0)
#pragma unroll
        for (int r = 0; r < 16; ++r) o[d0][r] = 0.f;
    float R = 0.f, m_reg = -1e30f, l_reg = 0.f, ctr = 0.f, qn = 0.f;
    if (TYPE == 1) {
        ctr = CB[qpos >> 6] + clr[qpos];
        float s = 0.f;
#pragma unroll
        for (int d0 = 0; d0 < 8; ++d0) { const u32x4 w = __builtin_bit_cast(u32x4, qr[d0]);
#pragma unroll
            for (int j = 0; j < 4; ++j) { const float a = __uint_as_float(w[j] << 16), b = __uint_as_float(w[j] & 0xffff0000u); s = fmaf(a, a, s); s = fmaf(b, b, s); } }
        s += partner(s, hi); qn = sqrtf(s) * 1.01f;
    }
    constexpr int NOPS = (TYPE == 1) ? 5 : 4;
    unsigned koff[2], voff[2];
#pragma unroll
    for (int j = 0; j < 2; ++j) { const int W = wid * 2 + j, row = 4 * W + (lane >> 4), c = (lane & 15) ^ (row & 7); koff[j] = (unsigned)(row * PITCH + c * 8);
        const int sv = 2 * W + (lane >> 5), kk = (sv >> 2) * 8 + ((lane & 31) >> 2), k = (kk & ~0xC) | ((kk & 4) << 1) | ((kk & 8) >> 1); voff[j] = (unsigned)(k * PITCH + (sv & 3) * 32 + (lane & 3) * 8); }
#define DMA_TILE(t_, ks_, vs_) do { const bf16_t* kt_ = Kg + (size_t)(t_) * KVBLK * PITCH; const bf16_t* vt_ = Vg + (size_t)(t_) * KVBLK * PITCH; \
        _Pragma("unroll") for (int j = 0; j < 2; ++j) __builtin_amdgcn_global_load_lds((const unsigned*)(kt_ + koff[j]), (LAS unsigned*)(lds + OFF_K + (ks_) * SHM + (wid * 2 + j) * 1024), 16, 0, 0); \
        _Pragma("unroll") for (int j = 0; j < 2; ++j) __builtin_amdgcn_global_load_lds((const unsigned*)(vt_ + voff[j]), (LAS unsigned*)(lds + (vs_) * SHM + (wid * 2 + j) * 1024), 16, 0, 0); \
        if (TYPE == 1) __builtin_amdgcn_global_load_lds((const unsigned*)(clr + (t_) * KVBLK + lane), (LAS unsigned*)(lds + OFF_CLB + (ks_) * 256), 4, 0, 0); } while (0)
#define WAIT_TILES(n_) asm volatile("s_waitcnt vmcnt(%0)" :: "n"(n_) : "memory")
#define STEP_BAR() do { asm volatile("s_waitcnt lgkmcnt(0)" ::: "memory"); __builtin_amdgcn_s_barrier(); asm volatile("" ::: "memory"); } while (0)
    DMA_TILE(NT - 1, 0, 0); DMA_TILE(NT - 2, 1, 1);
    WAIT_TILES(NOPS); STEP_BAR();
    f32x16 P0r, P1r; bf16x8 pa0, pa1, pa2, pa3;
    int k3 = 0, ilast = 0;
    for (int i = 0;; ++i) {
        const int t_ = NT - 1 - i, kb_ = t_ * KVBLK; const bool more_ = (i + 1 < NT), more2 = (i + 2 < NT);
        const bool actX = (kb_ <= qlo), actY = (i >= 1) && (kb_ + KVBLK <= qlo);
        float dr_ = 0.f;
        if (more2) DMA_TILE(t_ - 2, (k3 == 0 ? 2 : k3 - 1), (i + 2) & 3);
        if (actX) {
            if (TYPE == 1) { dr_ = ctr - CB[t_];
#pragma unroll
                for (int g = 0; g < 4; ++g) { const f32x4 c0 = *(LAS const f32x4*)(CLB + k3 * 64 + 8 * g + 4 * hi), c1 = *(LAS const f32x4*)(CLB + k3 * 64 + 32 + 8 * g + 4 * hi);
#pragma unroll
                    for (int j = 0; j < 4; ++j) { P0r[4 * g + j] = dr_ - c0[j]; P1r[4 * g + j] = dr_ - c1[j]; } } }
            else {
#pragma unroll
                for (int r = 0; r < 16; ++r) { P0r[r] = 0.f; P1r[r] = 0.f; } }
            SBAR(); qkt(P0r, P1r, lds + OFF_K + k3 * SHM, r32, hi, qr); }
        SBAR();
        if (actY) pv_tile(o, vbase + ((i - 1) & 3) * SHM, pa0, pa1, pa2, pa3);
        SBAR();
        bool done_ = false;
        if (actX) {
            if (TYPE == 1) { float alpha_; fox_part1(P0r, P1r, m_reg, alpha_, kb_ + KVBLK - 1 > qlo, qpos - kb_ - 4 * hi, hi);
                if (__any(alpha_ < 1.f)) { if (hi == 0) al_l[r32] = alpha_; asm volatile("s_waitcnt lgkmcnt(0)" ::: "memory");
#pragma unroll
                    for (int r = 0; r < 16; ++r) { const float a_ = al_l[crow(r, hi)];
#pragma unroll
                        for (int d_ = 0; d_ < 4; ++d_) o[d_][r] *= a_; } }
                fox_finish(P0r, P1r, alpha_, l_reg, pa0, pa1, pa2, pa3);
                done_ = (t_ >= 1) && __all(qn * KP[t_ >= 1 ? t_ - 1 : 0] + dr_ - m_reg < -1000.f); }
            else { sb_part1(P0r, P1r, R, kb_ + KVBLK - 1 >= qlo, qpos - kb_ - 4 * hi, hi); sb_finish(P0r, P1r, pa0, pa1, pa2, pa3); done_ = SB_EARLY_EXIT && __all(R > 128.0f); } }
        if (lane == 0) vote[(i & 1) * 8 + wid] = done_ ? 1 : 0;
        if (more2) WAIT_TILES(NOPS); else WAIT_TILES(0);
        STEP_BAR();
        int v_ = 1;
#pragma unroll
        for (int w_ = 0; w_ < 8; ++w_) v_ &= vote[(i & 1) * 8 + w_];
        if (v_ != 0 || !more_) { ilast = i; break; }
        k3 = (k3 == 2) ? 0 : k3 + 1;
    }
    if ((NT - 1 - ilast) * KVBLK <= qlo) pv_tile(o, vbase + (ilast & 3) * SHM, pa0, pa1, pa2, pa3);
    WAIT_TILES(0);
#undef DMA_TILE
#undef WAIT_TILES
#undef STEP_BAR
    head_epilogue<TYPE == 1>(o, l_reg, lds, wid, r32, hi, gain, Mrg, grow_b + qlo, gcol0);
    __syncthreads();
}
}

constexpr size_t MiB = 1u << 20;
constexpr size_t WS_CTL = 0, CTL_ZERO_BYTES = 2 * MiB;
constexpr size_t WS_WGU1 = 2 * MiB;
constexpr size_t WS_WD1 = WS_WGU1 + 172 * MiB;
constexpr size_t WS_WIN = WS_WD1 + 86 * MiB;
constexpr size_t WS_WF = WS_WIN + 96 * MiB;
constexpr size_t WS_WO = WS_WF + 1 * MiB;
constexpr size_t WS_WGU2 = WS_WO + 32 * MiB;
constexpr size_t WS_WD2 = WS_WGU2 + 172 * MiB;
constexpr size_t WS_AB = WS_WD2 + 86 * MiB;
constexpr size_t WS_MRG = WS_AB + 128 * MiB;
constexpr size_t WS_BIG = WS_MRG + 128 * MiB;
constexpr size_t WS_CL = WS_BIG + 384 * MiB;
constexpr size_t WS_CT = WS_CL + 1 * MiB;
constexpr size_t WS_END = WS_CT + 1 * MiB;
static_assert((size_t)2 * DFF * DM * 2 <= 172 * MiB && (size_t)DM * DFF * 2 <= 86 * MiB && (size_t)NQKV * DM * 2 <= 96 * MiB && (size_t)M * DFF * 2 <= 384 * MiB && (size_t)6 * M * GW * 2 <= 384 * MiB, "ws map");
constexpr int CW_BAR = 4096;
constexpr int CW_PNL = 12288;
constexpr int CW_GQ = 32768;
constexpr int CW_CONV = 16384 + 4096;
constexpr int CW_Q = 8192;
constexpr size_t CTL_RSS = 1 * MiB;

constexpr int RING_BYTES = 131072, LDSCTL_OFF = RING_BYTES, MISC_OFF = LDSCTL_OFF + 320, LDS_BYTES = 147456;
static_assert(att::ATT_LDS_BYTES <= RING_BYTES, "attention scratch inside the ring");

#define XB_TMO      128
#define XB_XCNT(j)  (256  + 64 * (j))
#define XB_XSUB(j)  (1280 + 64 * (j))
#define XB_XGEN(j)  (2304 + 64 * (j))
#define XB_TOP      3328
#define XB_TOPGEN   3392
#define XCD_BAR_WORDS 3456
#define XB_SPIN_CAP (1u << 18)
__device__ __forceinline__ unsigned xb_ld(unsigned* p)              { return __hip_atomic_load(p, __ATOMIC_RELAXED, __HIP_MEMORY_SCOPE_AGENT); }
__device__ __forceinline__ unsigned xb_add(unsigned* p, unsigned v) { return __hip_atomic_fetch_add(p, v, __ATOMIC_RELAXED, __HIP_MEMORY_SCOPE_AGENT); }
__device__ __forceinline__ unsigned xb_xcc_id() { return (unsigned)__builtin_amdgcn_s_getreg((3 << 11) | 20) & 0xFu; }
#define XB_SPIN(cond, bar) do { unsigned _sp = 0; while (cond) { __builtin_amdgcn_s_sleep(1); \
    if ((++_sp & 255u) == 0u) { if (xb_ld(&(bar)[XB_TMO])) break; if (_sp > XB_SPIN_CAP) { atomicAdd(&(bar)[XB_TMO], 1u); break; } } } } while (0)
struct XcdBarrier { unsigned* bar; unsigned x; volatile LAS unsigned* st; };
__device__ __forceinline__ XcdBarrier xcd_barrier_post(unsigned* bar, volatile LAS unsigned* st) {
    XcdBarrier b; b.bar = bar; b.x = xb_xcc_id(); b.st = st;
    if (threadIdx.x == 0) (void)xb_add(&bar[XB_XCNT(b.x)], 1u);
    return b;
}
__device__ __forceinline__ void xcd_barrier_complete(unsigned* bar, unsigned x, unsigned& nloc, unsigned& nx) {
    const unsigned G = gridDim.x * gridDim.y * gridDim.z;
    unsigned sum, cnt, mine, sp = 0u;
    for (;;) {
        sum = 0u; cnt = 0u; mine = 0u;
#pragma unroll
        for (unsigned j = 0; j < 16; ++j) { const unsigned c = xb_ld(&bar[XB_XCNT(j)]); sum += c; cnt += (c > 0u) ? 1u : 0u; mine = (j == x) ? c : mine; }
        if (sum == G) break;
        __builtin_amdgcn_s_sleep(1);
        if ((++sp & 255u) == 0u) { if (xb_ld(&bar[XB_TMO])) break; if (sp > XB_SPIN_CAP) { atomicAdd(&bar[XB_TMO], 1u); break; } }
    }
    nloc = mine > 0u ? mine : 1u; nx = cnt > 0u ? cnt : 1u;
}
__device__ __forceinline__ void xcd_barrier(const XcdBarrier& b) {
    asm volatile("s_waitcnt vmcnt(0)" ::: "memory");
    __syncthreads();
    if (threadIdx.x == 0) {
        unsigned* bar = b.bar;
        __builtin_amdgcn_s_waitcnt(0);
        unsigned nloc = b.st[0], nx = b.st[1];
        if (nloc == 0u) { xcd_barrier_complete(bar, b.x, nloc, nx); b.st[0] = nloc; b.st[1] = nx; }
        const unsigned old = xb_add(&bar[XB_XSUB(b.x)], 1u);
        const unsigned gen = old / nloc;
        if (old + 1u == (gen + 1u) * nloc) {
            __builtin_amdgcn_fence(__ATOMIC_RELEASE, "agent");
            asm volatile("s_waitcnt vmcnt(0)" ::: "memory");
            const unsigned og = xb_add(&bar[XB_TOP], 1u);
            const unsigned tg = og / nx;
            if (og + 1u == (tg + 1u) * nx) xb_add(&bar[XB_TOPGEN], 1u);
            else XB_SPIN(xb_ld(&bar[XB_TOPGEN]) == tg, bar);
            __builtin_amdgcn_fence(__ATOMIC_ACQUIRE, "agent");
            xb_add(&bar[XB_XGEN(b.x)], 1u);
            asm volatile("s_waitcnt vmcnt(0)" ::: "memory");
        } else {
            XB_SPIN(xb_ld(&bar[XB_XGEN(b.x)]) == gen, bar);
            __builtin_amdgcn_fence(__ATOMIC_ACQUIRE, "agent");
            asm volatile("s_waitcnt vmcnt(0)" ::: "memory");
        }
    }
    __syncthreads();
}

__device__ __forceinline__ unsigned f2bf(float f) { unsigned u = __builtin_bit_cast(unsigned, f); return (u + 0x7fffu + ((u >> 16) & 1u)) >> 16; }
__device__ __forceinline__ unsigned pk2(float lo, float hi) { return f2bf(lo) | (f2bf(hi) << 16); }
__device__ __forceinline__ float wave_sum(float v) {
#pragma unroll
    for (int o = 1; o < 64; o <<= 1) v += __shfl_xor(v, o);
    return v;
}
__device__ __forceinline__ void tr_item(const float* W, int ldw, int K, int k0, int n0, int nvalid, const float* gain, bf16_t* WT, int orow0, LAS float* scr, int lane, bool image = true) {
    const int nl = lane & 31; const bool ok = nl < nvalid;
    float v[32];
#pragma unroll
    for (int i = 0; i < 32; ++i) { const int kk = 2 * i + (lane >> 5); v[i] = ok ? __builtin_nontemporal_load(W + (size_t)(k0 + kk) * ldw + n0 + nl) : 0.f; }
    if (gain) {
#pragma unroll
        for (int i = 0; i < 32; ++i) { const int kk = 2 * i + (lane >> 5); v[i] *= gain[k0 + kk]; } }
#pragma unroll
    for (int i = 0; i < 32; ++i) { const int kk = 2 * i + (lane >> 5); scr[kk * 33 + nl] = v[i]; }
    asm volatile("s_waitcnt lgkmcnt(0)" ::: "memory");
    const int c = lane & 7;
#pragma unroll
    for (int j = 0; j < 4; ++j) { const int n = (lane >> 3) + 8 * j; const LAS float* s = scr + (8 * c) * 33 + n;
        u32x4 o; o.x = pk2(s[0 * 33], s[1 * 33]); o.y = pk2(s[2 * 33], s[3 * 33]); o.z = pk2(s[4 * 33], s[5 * 33]); o.w = pk2(s[6 * 33], s[7 * 33]);
        if (n < nvalid) *(u32x4*)(WT + (image ? pg8::img_off_b(orow0 + n, k0 + 8 * c, K) : (size_t)(orow0 + n) * K + k0 + 8 * c)) = o; }
    asm volatile("s_waitcnt lgkmcnt(0)" ::: "memory");
}

struct Args { const float* in[16]; float* out; unsigned char* ws; int ph_lo, ph_hi, flag, pad; };
constexpr int NPH = 9;

__global__ void __launch_bounds__(512, 2) mk_fwd(Args args) {
    extern __shared__ __attribute__((aligned(16))) unsigned char lds_raw[];
    LAS unsigned char* lds = (LAS unsigned char*)lds_raw;
    volatile LAS unsigned* MISC = (volatile LAS unsigned*)(lds + MISC_OFF);
    const int tid = threadIdx.x, lane = tid & 63, wave = __builtin_amdgcn_readfirstlane(tid >> 6);
    const int G = gridDim.x, bx = blockIdx.x;
    const int vcu = (G % 8 == 0) ? (bx % 8) * (G / 8) + bx / 8 : bx;
    unsigned char* ws = args.ws;
    unsigned* ctl = (unsigned*)(ws + WS_CTL);
    const float* x = args.in[0]; const float* g_ffn1 = args.in[1]; const float* w_gate1 = args.in[2]; const float* w_up1 = args.in[3]; const float* w_down1 = args.in[4];
    const float* g_mix = args.in[5]; const float* w_in = args.in[6]; const float* b_f = args.in[7]; const float* g_sb = args.in[8]; const float* g_fox = args.in[9];
    const float* w_o = args.in[10]; const float* g_ffn2 = args.in[11]; const float* w_gate2 = args.in[12]; const float* w_up2 = args.in[13]; const float* w_down2 = args.in[14];
    const float* g_fin = args.in[15];
    float* out = args.out;
    bf16_t* Wgu1 = (bf16_t*)(ws + WS_WGU1); bf16_t* Wd1 = (bf16_t*)(ws + WS_WD1); bf16_t* Win = (bf16_t*)(ws + WS_WIN); bf16_t* Wf = (bf16_t*)(ws + WS_WF);
    bf16_t* Wo = (bf16_t*)(ws + WS_WO); bf16_t* Wgu2 = (bf16_t*)(ws + WS_WGU2); bf16_t* Wd2 = (bf16_t*)(ws + WS_WD2);
    bf16_t* AB = (bf16_t*)(ws + WS_AB); bf16_t* MRG = (bf16_t*)(ws + WS_MRG); bf16_t* BIG = (bf16_t*)(ws + WS_BIG);
    float* CL = (float*)(ws + WS_CL); float* CT = (float*)(ws + WS_CT);
    float* rss0 = (float*)(ws + CTL_RSS); float* rss1 = rss0 + M; float* rss2 = rss1 + M; float* rss3 = rss2 + M; float* tmx = rss3 + M;

    for (int u = tid; u < (LDS_BYTES - LDSCTL_OFF) / 4; u += 512) ((LAS unsigned*)(lds + LDSCTL_OFF))[u] = 0u;
    __syncthreads();
    XcdBarrier bar; bar.bar = ctl + CW_BAR; bar.x = 0; bar.st = nullptr;
    if (MK_N_LAUNCHES == 1) bar = xcd_barrier_post(ctl + CW_BAR, MISC + 8);
    const int lo = args.ph_lo, hi_ph = args.ph_hi;
#define IN(k) (lo <= (k) && (k) < hi_ph)
#define SEAM(k) do { if (IN(k) && IN((k) + 1)) xcd_barrier(bar); } while (0)

    constexpr int CV_KB_D = DM / 64, CV_KB_F = DFF / 64, CV_NB_F = DFF / 32, CV_NB_D = DM / 32, CV_NB_Q = NQKV / 32;
    constexpr int CV_I_G = CV_KB_D * CV_NB_F, CV_I_DN = CV_KB_F * CV_NB_D, CV_I_IN = CV_KB_D * (CV_NB_Q + 1), CV_I_O = CV_KB_D * CV_NB_D;
    constexpr int CV_GU2 = 2 * CV_I_G, CV_DN1 = 4 * CV_I_G, CV_DN2 = CV_DN1 + CV_I_DN, CV_IN = CV_DN2 + CV_I_DN, CV_O = CV_IN + CV_I_IN;
    constexpr int CV_BATCH = 4;
#define CONV_TAIL(k_, lo_, n_) do { \
        constexpr int KB_D = CV_KB_D, KB_F = CV_KB_F, NB_F = CV_NB_F, NB_D = CV_NB_D, NB_Q = CV_NB_Q, I_G = CV_I_G, I_DN = CV_I_DN, I_IN = CV_I_IN; \
        (void)KB_D; (void)KB_F; \
        LAS float* scr = (LAS float*)(lds + wave * 16384); \
        volatile LAS int* cslot_ = (volatile LAS int*)(lds + LDS_BYTES - 32); \
        for (;;) { if (tid == 0) *cslot_ = (int)xb_add(ctl + CW_CONV + 64 * (k_), (unsigned)(8 * CV_BATCH)); \
            __syncthreads(); const int base_ = __builtin_amdgcn_readfirstlane(*cslot_); __syncthreads(); \
            if (base_ >= (n_)) break; \
            for (int i_ = 0; i_ < CV_BATCH; ++i_) { const int it_ = base_ + i_ * 8 + wave; if (it_ < (n_)) CONV_ITEM((lo_) + it_); } } \
    } while (0)

    if (IN(0)) {
        LAS float* scr = (LAS float*)(lds + wave * 16384);
        const int gw = vcu * 8 + wave, NGW = G * 8;
        constexpr int KB_D = DM / 64, KB_F = DFF / 64;
        constexpr int NB_F = DFF / 32, NB_D = DM / 32, NB_Q = NQKV / 32;
        constexpr int I_G = KB_D * NB_F, I_DN = KB_F * NB_D, I_IN = KB_D * (NB_Q + 1), I_O = KB_D * NB_D;
        constexpr int NITEMS = 4 * I_G + 2 * I_DN + I_IN + I_O;
#define CONV_ITEM(it_) do { const int it = (it_); \
            int r = it; \
            if (r < 4 * I_G) { \
                const int which = r / I_G; r -= which * I_G; const int kb = r / NB_F, nb = r % NB_F, n0 = nb * 32; \
                const float* W = which == 0 ? w_gate1 : which == 1 ? w_up1 : which == 2 ? w_gate2 : w_up2; \
                bf16_t* WT = which < 2 ? Wgu1 : Wgu2; const float* gn = which < 2 ? g_ffn1 : g_ffn2; \
                const int orow0 = (n0 >> 7) * 256 + (which & 1) * 128 + (n0 & 127); \
                tr_item(W, DFF, DM, kb * 64, n0, 32, gn, WT, orow0, scr, lane); break; } \
            r -= 4 * I_G; \
            if (r < 2 * I_DN) { \
                const int which = r / I_DN; r -= which * I_DN; const int kb = r / NB_D, nb = r % NB_D; \
                tr_item(which ? w_down2 : w_down1, DM, DFF, kb * 64, nb * 32, 32, nullptr, which ? Wd2 : Wd1, nb * 32, scr, lane); break; } \
            r -= 2 * I_DN; \
            if (r < I_IN) { \
                const int kb = r / (NB_Q + 1), nb = r % (NB_Q + 1); \
                if (nb < NB_Q) tr_item(w_in, IN_PROJ, DM, kb * 64, nb * 32, 32, g_mix, Win, nb * 32, scr, lane); \
                else tr_item(w_in, IN_PROJ, DM, kb * 64, NQKV, 16, g_mix, Wf, 0, scr, lane, false); \
                break; } \
            r -= I_IN; \
            { const int kb = r / NB_D, nb = r % NB_D; tr_item(w_o, DM, DM, kb * 64, nb * 32, 32, nullptr, Wo, nb * 32, scr, lane); } \
        } while (0)
        (void)NITEMS;
        for (int j = gw; j < 2 * I_G; j += NGW) CONV_ITEM(j);
        for (int m = gw; m < M; m += NGW) {
            const f32x4* xr = (const f32x4*)(x + (size_t)m * DM) + lane; float ss = 0.f; f32x4 v[16];
#pragma unroll
            for (int j = 0; j < 16; ++j) { v[j] = __builtin_nontemporal_load(xr + 64 * j); ss += (v[j][0] * v[j][0] + v[j][1] * v[j][1]) + (v[j][2] * v[j][2] + v[j][3] * v[j][3]); }
            ss = wave_sum(ss);
            if (lane == 0) rss0[m] = ss;
#pragma unroll
            for (int j = 0; j < 16; ++j) { u32x2 w; w.x = cvt_pk_bf16(v[j][0], v[j][1]); w.y = cvt_pk_bf16(v[j][2], v[j][3]); *(u32x2*)(AB + pg8::img_off(m, 4 * (lane + 64 * j), DM)) = w; }
        }
    }
    SEAM(0);

    if (IN(1)) {
        pg8::Gemm g{AB, Wgu1, M, 2 * DFF, DM}; pg8::DynOrder S{ctl + CW_GQ, 8 * (2 * DFF / pg8::BM), (int)(xb_xcc_id() & 7u), (volatile LAS int*)(lds + LDS_BYTES - 64)};
        pg8::EpiSwiglu E{BIG, rss0};
        pg8::gemm_phase<pg8::EpiSwiglu, pg8::DynOrder, true, true>(lds, g, S, E);
        CONV_TAIL(0, CV_DN1, CV_I_DN);
    }
    SEAM(1);
    if (IN(2)) {
        pg8::Gemm g{BIG, Wd1, M, DM, DFF}; pg8::StaticOrder S; S.init(M, DM, G, bx, 2);
        pg8::EpiResid<true, false> E{AB, AB, rss1, 0.5f};
        pg8::gemm_phase<pg8::EpiResid<true, false>, pg8::StaticOrder, true, true>(lds, g, S, E);
        CONV_TAIL(1, CV_IN, CV_I_IN);
    }
    SEAM(2);
    if (IN(3)) {
        {
        pg8::Gemm g{AB, Win, M, NQKV, DM}; pg8::DynOrder S{ctl + CW_GQ + 512, 8 * (NQKV / pg8::BM), (int)(xb_xcc_id() & 7u), (volatile LAS int*)(lds + LDS_BYTES - 64)};
        pg8::EpiQKV E{BIG, rss1, tmx};
        pg8::gemm_phase<pg8::EpiQKV, pg8::DynOrder, true, true>(lds, g, S, E);
        }
        LAS float* lf = (LAS float*)lds;
        LAS float* lf2 = lf + 64 * 16;
        for (int ch = vcu; ch < M / 64; ch += G) {
            const int fr = lane & 15, fq = lane >> 4, w4 = wave & 3, kh = wave >> 2; const int rowA = ch * 64 + w4 * 16 + fr;
            const bf16_t* bp = Wf + (size_t)fr * DM + fq * 8;
            f32x4 acc = {0.f, 0.f, 0.f, 0.f};
#pragma unroll 8
            for (int k0 = kh * (DM / 2); k0 < (kh + 1) * (DM / 2); k0 += 32) acc = __builtin_amdgcn_mfma_f32_16x16x32_bf16(*(const bf16x8*)(AB + pg8::img_off(rowA, k0 + fq * 8, DM)), *(const bf16x8*)(bp + k0), acc, 0, 0, 0);
            if (kh == 1) {
#pragma unroll
                for (int j = 0; j < 4; ++j) lf2[(w4 * 16 + fq * 4 + j) * 16 + fr] = acc[j]; }
            __syncthreads();
            if (wave < 4) {
                const float bias = b_f[fr];
#pragma unroll
                for (int j = 0; j < 4; ++j) { const int rl = wave * 16 + fq * 4 + j; const float r = rstd_of(ld_agent_f32(rss1 + ch * 64 + rl));
                    const float v = (acc[j] + lf2[rl * 16 + fr]) * r + bias; const float ls = fminf(v, 0.f) - log1pf(expf(-fabsf(v))); lf[rl * 16 + fr] = ls; }
            }
            __syncthreads();
            if (tid < 16) { const int b = (ch * 64) / SEQ, s0 = (ch * 64) % SEQ; float run = 0.f; float* clp = CL + ((size_t)(b * NH + tid)) * SEQ + s0;
                for (int r = 0; r < 64; ++r) { run += lf[r * 16 + tid]; clp[r] = run * (1.0f / att::SCALE); }
                CT[(b * NH + tid) * 128 + (s0 >> 6)] = run * (1.0f / att::SCALE); }
            __syncthreads();
        }
        CONV_TAIL(5, CV_GU2, CV_I_G);
    }
    SEAM(3);
    if (IN(4)) {
        const size_t TS = (size_t)M * GW;
        const int myq = (int)(xb_xcc_id() & 7u);
        volatile LAS int* slot = (volatile LAS int*)(lds + att::OFF_SLOT);
        unsigned* qf = ctl + CW_Q + args.flag * 1024; unsigned* qs = qf + 8 * 64;
        int last_bh = -1;
        for (;;) {
            if (tid == 0) { int res = -1; for (int k = 0; k < 8; ++k) { const int q = (myq + k) & 7; const unsigned idx = xb_add(qf + 64 * q, 1u); if (idx < 128u) { res = q * 128 + (int)idx; break; } } *slot = res; }
            __syncthreads(); const int it = *slot; __syncthreads();
            if (it < 0) break;
            const int q = it >> 7, j = it & 127, bh = (j >> 5) * 8 + q, qb = 31 - (j & 31), b = bh >> 4, h = bh & 15;
            const size_t base = (size_t)b * SEQ * GW + (size_t)h * HD;
            if (bh != last_bh) {
                if (wave == 0) {
                    const float* ct = CT + bh * 128; const float v0 = ct[2 * lane], v1 = ct[2 * lane + 1]; const float s = v0 + v1; float inc = s;
#pragma unroll
                    for (int o = 1; o < 64; o <<= 1) { const float tq = __shfl_up(inc, o); if (lane >= o) inc += tq; }
                    const float ex = inc - s; LAS float* CBw = (LAS float*)(lds + att::OFF_CB); CBw[2 * lane] = ex; CBw[2 * lane + 1] = ex + v0; }
                if (wave == 1) {
                    const float v0 = sqrtf(ld_agent_f32(tmx + bh * 128 + 2 * lane)) * 1.01f, v1 = sqrtf(ld_agent_f32(tmx + bh * 128 + 2 * lane + 1)) * 1.01f; float inc = fmaxf(v0, v1);
#pragma unroll
                    for (int o = 1; o < 64; o <<= 1) { const float tq = __shfl_up(inc, o); if (lane >= o) inc = fmaxf(inc, tq); }
                    float ex = __shfl_up(inc, 1); if (lane == 0) ex = 0.f;
                    LAS float* KPw = (LAS float*)(lds + att::OFF_KP); KPw[2 * lane] = fmaxf(ex, v0); KPw[2 * lane + 1] = inc; }
                __syncthreads(); last_bh = bh;
            }
            att::attn_block<1>(BIG + 3 * TS + base, BIG + 4 * TS + base, BIG + 5 * TS + base, MRG, b * SEQ, GW + h * HD, g_fox + h * HD,
                               CL + (size_t)bh * SEQ, qb * att::QB, lds);
        }
        for (;;) {
            if (tid == 0) { int res = -1; for (int k = 0; k < 8; ++k) { const int q = (myq + k) & 7; const unsigned idx = xb_add(qs + 64 * q, 1u); if (idx < 128u) { res = q * 128 + (int)idx; break; } } *slot = res; }
            __syncthreads(); const int it = *slot; __syncthreads();
            if (it < 0) break;
            const int q = it >> 7, j = it & 127, bh = (j >> 5) * 8 + q, qb = 31 - (j & 31), b = bh >> 4, h = bh & 15;
            const size_t base = (size_t)b * SEQ * GW + (size_t)h * HD;
            att::attn_block<0>(BIG + base, BIG + TS + base, BIG + 2 * TS + base, MRG, b * SEQ, h * HD, g_sb + h * HD, nullptr, qb * att::QB, lds);
        }
        CONV_TAIL(2, CV_O, CV_I_O);
    }
    SEAM(4);
    if (IN(5)) {
        pg8::Gemm g{MRG, Wo, M, DM, DM}; pg8::StaticOrder S; S.init(M, DM, G, bx, 2);
        pg8::EpiResid<true, false> E{AB, AB, rss2, 1.0f};
        pg8::gemm_phase<pg8::EpiResid<true, false>, pg8::StaticOrder, true, true>(lds, g, S, E);
        CONV_TAIL(3, CV_GU2 + CV_I_G, CV_I_G);
    }
    SEAM(5);
    if (IN(6)) {
        pg8::Gemm g{AB, Wgu2, M, 2 * DFF, DM}; pg8::DynOrder S{ctl + CW_GQ + 1024, 8 * (2 * DFF / pg8::BM), (int)(xb_xcc_id() & 7u), (volatile LAS int*)(lds + LDS_BYTES - 64)};
        pg8::EpiSwiglu E{BIG, rss2};
        pg8::gemm_phase<pg8::EpiSwiglu, pg8::DynOrder, true, true>(lds, g, S, E);
        CONV_TAIL(4, CV_DN2, CV_I_DN);
    }
    SEAM(6);
    if (IN(7)) {
        pg8::Gemm g{BIG, Wd2, M, DM, DFF}; pg8::StaticOrder S; S.init(M, DM, G, bx, 2);
        if (G == 256) {
            pg8::EpiResidNorm E{AB, out, rss3, ctl + CW_PNL, g_fin, 0.5f};
            pg8::gemm_phase<pg8::EpiResidNorm, pg8::StaticOrder, true, true>(lds, g, S, E);
        } else {
            pg8::EpiResid<true, true> E{AB, out, rss3, 0.5f};
            pg8::gemm_phase<pg8::EpiResid<true, true>, pg8::StaticOrder, true, true>(lds, g, S, E);
        }
    }
    if (G != 256) SEAM(7);
    if (IN(8) && G != 256) {
        const int gw = vcu * 8 + wave, NGW = G * 8;
        for (int m = gw; m < M; m += NGW) {
            const float r = rstd_of(ld_agent_f32(rss3 + m)); f32x4* xr = (f32x4*)(out + (size_t)m * DM) + lane; const f32x4* gr = (const f32x4*)g_fin + lane;
#pragma unroll
            for (int j = 0; j < 16; ++j) { const f32x4 v = xr[64 * j] * r * gr[64 * j]; xr[64 * j] = v; }
        }
    }
#undef IN
#undef SEAM
#undef CONV_ITEM
#undef CONV_TAIL
}

extern "C" void kernel_launch(void* const* d_in, const int* in_sizes, int n_in, void* d_out, int out_size, void* d_ws, size_t ws_size, hipStream_t stream) {
    static int grid = 0;
    if (grid == 0) {
        if (n_in != 16 || in_sizes[0] != M * DM || out_size != M * DM || ws_size < WS_END + MiB) {
            fprintf(stderr, "kernel_launch: shape/workspace mismatch (n_in %d in0 %d out %d ws %zu need %zu); nothing launched\n", n_in, n_in > 0 ? in_sizes[0] : -1, out_size, ws_size, (size_t)WS_END); grid = -1; return; }
        int dev = 0, cus = 0, per_cu = 0;
        if (hipGetDevice(&dev) != hipSuccess || hipDeviceGetAttribute(&cus, hipDeviceAttributeMultiprocessorCount, dev) != hipSuccess) { fprintf(stderr, "kernel_launch: device query failed\n"); grid = -1; return; }
        if (hipFuncSetAttribute((const void*)mk_fwd, hipFuncAttributeMaxDynamicSharedMemorySize, LDS_BYTES) != hipSuccess) { fprintf(stderr, "kernel_launch: hipFuncSetAttribute failed\n"); grid = -1; return; }
        if (hipOccupancyMaxActiveBlocksPerMultiprocessor(&per_cu, (const void*)mk_fwd, 512, LDS_BYTES) != hipSuccess || per_cu < 1)
            fprintf(stderr, "kernel_launch: note: occupancy query reports %d workgroups per CU\n", per_cu);
        (void)hipGetLastError();
        grid = cus;
    }
    if (grid < 0) return;
    (void)hipMemsetAsync((char*)d_ws + WS_CTL, 0, CTL_ZERO_BYTES, stream);
    Args a{};
    for (int i = 0; i < 16; ++i) a.in[i] = (const float*)d_in[i];
    a.out = (float*)d_out; a.ws = (unsigned char*)d_ws;
    if (MK_N_LAUNCHES == 1) { a.ph_lo = 0; a.ph_hi = NPH; hipLaunchKernelGGL(mk_fwd, dim3(grid), dim3(512), LDS_BYTES, stream, a); }
    else for (int p = 0; p < NPH; ++p) { a.ph_lo = p; a.ph_hi = p + 1; for (int rep = 0; rep < (p == PROBE_REP ? 2 : 1); ++rep) { a.flag = rep; hipLaunchKernelGGL(mk_fwd, dim3(grid), dim3(512), LDS_BYTES, stream, a); } }
    const hipError_t le = hipPeekAtLastError();
    if (le != hipSuccess) fprintf(stderr, "kernel_launch: launch failed: %s\n", hipGetErrorName(le));
}
```
